# Optimizing an MI355X kernel written in HIP

```python
import jax, jax.numpy as jnp
from jax import lax
import numpy as np

D_MODEL = 1024
BATCH = 8
SEQ = 4096
DEPTH = 1

CHUNK = 64
Q_BLOCK = 128
MIX_WIDTH = D_MODEL
MLA_HEADS = 4
QK_NOPE_DIM = 128
QK_ROPE_DIM = 64
V_HEAD_DIM = 128
Q_LORA_RANK = 256
KV_LORA_RANK = 128
MLA_WIDTH = MLA_HEADS * V_HEAD_DIM
POOL_WIDTH = MIX_WIDTH - MLA_WIDTH
POOL_WINDOWS = (2, 4, 8, 16)
POOL_GROUPS = len(POOL_WINDOWS)
POOL_GROUP_DIM = POOL_WIDTH // POOL_GROUPS
IN_COLS = Q_LORA_RANK + KV_LORA_RANK + QK_ROPE_DIM + POOL_WIDTH
D_FF = ((8 * D_MODEL + 3 * 256 - 1) // (3 * 256)) * 256
ROPE_THETA = 10000.0
EPS = 1e-6
SM_SCALE = (QK_NOPE_DIM + QK_ROPE_DIM) ** -0.5
N_MOD = 6

kernel_name = "hybrid_mla_pool_adaln_block"


def rmsnorm(x, g):
    xf = x.astype(jnp.float32)
    y = xf * lax.rsqrt(jnp.mean(xf * xf, axis=-1, keepdims=True) + EPS)
    return (y * g.astype(jnp.float32)).astype(x.dtype)


def rope_tables(positions, dtype):
    half = QK_ROPE_DIM // 2
    freqs = jnp.power(ROPE_THETA, -jnp.arange(half, dtype=jnp.float32) / half)
    ang = positions.astype(jnp.float32)[..., None] * freqs
    return jnp.cos(ang).astype(dtype), jnp.sin(ang).astype(dtype)


def apply_rope(x, cos, sin):
    x1, x2 = jnp.split(x, 2, axis=-1)
    return jnp.concatenate([x1 * cos - x2 * sin, x1 * sin + x2 * cos], axis=-1)


def mla_mixer(cq_raw, ckv_raw, kr_raw, positions, g_q, g_kv, w_uq, w_uk, w_uv):
    B, S, _ = ckv_raw.shape
    c_q = rmsnorm(cq_raw, g_q)
    c_kv = rmsnorm(ckv_raw, g_kv)
    q = jnp.einsum('bsr,rhd->bshd', c_q, w_uq)
    q_nope, q_rope = q[..., :QK_NOPE_DIM], q[..., QK_NOPE_DIM:]
    cos, sin = rope_tables(positions, q.dtype)
    q_rope = apply_rope(q_rope, cos[:, :, None, :], sin[:, :, None, :])
    k_rope = apply_rope(kr_raw, cos, sin)
    q_lat = jnp.einsum('bshd,chd->bshc', q_nope, w_uk)
    nblk = S // Q_BLOCK
    q_lat_b = q_lat.reshape(B, nblk, Q_BLOCK, MLA_HEADS, KV_LORA_RANK).transpose(1, 0, 2, 3, 4)
    q_rope_b = q_rope.reshape(B, nblk, Q_BLOCK, MLA_HEADS, QK_ROPE_DIM).transpose(1, 0, 2, 3, 4)
    key_chunk = jnp.arange(S) // CHUNK

    def block(args):
        ql, qr, blk = args
        s = (jnp.einsum('bqhc,bkc->bhqk', ql, c_kv)
             + jnp.einsum('bqhr,bkr->bhqk', qr, k_rope)).astype(jnp.float32) * SM_SCALE
        q_chunk = (blk * Q_BLOCK + jnp.arange(Q_BLOCK)) // CHUNK
        mask = key_chunk[None, :] <= q_chunk[:, None]
        s = jnp.where(mask[None, None], s, -jnp.inf)
        p = jax.nn.softmax(s, axis=-1).astype(c_kv.dtype)
        o_lat = jnp.einsum('bhqk,bkc->bqhc', p, c_kv)
        o = jnp.einsum('bqhc,chv->bqhv', o_lat, w_uv)
        return o.reshape(B, Q_BLOCK, MLA_WIDTH)

    out = lax.map(block, (q_lat_b, q_rope_b, jnp.arange(nblk)))
    return out.transpose(1, 0, 2, 3).reshape(B, S, MLA_WIDTH)


def pool_mixer(u, w_pool, pool_scale):
    B, S, _ = u.shape
    ug = u.reshape(B, S, POOL_GROUPS, POOL_GROUP_DIM)
    cs = jnp.cumsum(ug.astype(jnp.float32), axis=1)
    t = jnp.arange(1, S + 1, dtype=jnp.float32)
    pooled = []
    for g, w in enumerate(POOL_WINDOWS):
        csg = cs[:, :, g]
        lagged = jnp.pad(csg, ((0, 0), (w, 0), (0, 0)))[:, :S]
        count = jnp.minimum(t, float(w))[None, :, None]
        pooled.append((csg - lagged) / count)
    pooled = jnp.stack(pooled, axis=2).astype(u.dtype) - ug
    y = jnp.einsum('bsgc,gcd->bsgd', pooled, w_pool).reshape(B, S, POOL_WIDTH)
    return y * pool_scale


def setup_inputs(seed: int = 0) -> dict:
    key = jax.random.key(seed)
    ks = jax.random.split(key, 24)
    f32 = jnp.float32
    nrm = lambda k, shape, s: jax.random.normal(k, shape, f32) * s
    gain = lambda k, shape: 1.0 + 0.05 * jax.random.normal(k, shape, f32)
    x = jax.random.normal(ks[0], (BATCH, SEQ, D_MODEL), f32)
    c = jax.random.normal(ks[1], (BATCH, D_MODEL), f32)
    offset = jax.random.randint(ks[2], (BATCH, 1), 0, 8192, dtype=jnp.int32)
    positions = offset + jnp.arange(SEQ, dtype=jnp.int32)[None, :]
    return {
        "x": x,
        "c": c,
        "positions": positions,
        "w_ada": nrm(ks[3], (DEPTH, D_MODEL, N_MOD * D_MODEL), 0.5 * D_MODEL ** -0.5),
        "b_ada": nrm(ks[4], (DEPTH, N_MOD * D_MODEL), 0.02),
        "g_mix": gain(ks[5], (DEPTH, D_MODEL)),
        "w_in": nrm(ks[6], (DEPTH, D_MODEL, IN_COLS), D_MODEL ** -0.5),
        "g_q": gain(ks[7], (DEPTH, Q_LORA_RANK)),
        "g_kv": gain(ks[8], (DEPTH, KV_LORA_RANK)),
        "w_uq": nrm(ks[9], (DEPTH, Q_LORA_RANK, MLA_HEADS, QK_NOPE_DIM + QK_ROPE_DIM), Q_LORA_RANK ** -0.5),
        "w_uk": nrm(ks[10], (DEPTH, KV_LORA_RANK, MLA_HEADS, QK_NOPE_DIM), KV_LORA_RANK ** -0.5),
        "w_uv": nrm(ks[11], (DEPTH, KV_LORA_RANK, MLA_HEADS, V_HEAD_DIM), KV_LORA_RANK ** -0.5),
        "w_pool": nrm(ks[12], (DEPTH, POOL_GROUPS, POOL_GROUP_DIM, POOL_GROUP_DIM), POOL_GROUP_DIM ** -0.5),
        "pool_scale": gain(ks[13], (DEPTH, POOL_WIDTH)),
        "w_o": nrm(ks[14], (DEPTH, MIX_WIDTH, D_MODEL), MIX_WIDTH ** -0.5),
        "g_ffn": gain(ks[15], (DEPTH, D_MODEL)),
        "w_gate": nrm(ks[16], (DEPTH, D_MODEL, D_FF), D_MODEL ** -0.5),
        "w_up": nrm(ks[17], (DEPTH, D_MODEL, D_FF), D_MODEL ** -0.5),
        "w_down": nrm(ks[18], (DEPTH, D_FF, D_MODEL), D_FF ** -0.5),
        "g_final": gain(ks[19], (D_MODEL,)),
    }


def reference(x, c, positions, w_ada, b_ada, g_mix, w_in, g_q, g_kv, w_uq, w_uk,
              w_uv, w_pool, pool_scale, w_o, g_ffn, w_gate, w_up, w_down, g_final):
    c_act = jax.nn.silu(c)
    for l in range(DEPTH):
        mod = (c_act @ w_ada[l] + b_ada[l])[:, None, :]
        sh1, sc1, gt1, sh2, sc2, gt2 = jnp.split(mod, N_MOD, axis=-1)

        h = rmsnorm(x, g_mix[l]) * (1.0 + sc1) + sh1
        proj = h @ w_in[l]
        o1 = Q_LORA_RANK
        o2 = o1 + KV_LORA_RANK
        o3 = o2 + QK_ROPE_DIM
        y_mla = mla_mixer(proj[..., :o1], proj[..., o1:o2], proj[..., o2:o3], positions,
                          g_q[l], g_kv[l], w_uq[l], w_uk[l], w_uv[l])
        y_pool = pool_mixer(proj[..., o3:], w_pool[l], pool_scale[l])
        mix = jnp.concatenate([y_mla, y_pool], axis=-1) @ w_o[l]
        x = x + gt1 * mix

        h = rmsnorm(x, g_ffn[l]) * (1.0 + sc2) + sh2
        ff = (jax.nn.silu(h @ w_gate[l]) * (h @ w_up[l])) @ w_down[l]
        x = x + gt2 * ff
    return rmsnorm(x, g_final)
```

```cpp
#include <hip/hip_runtime.h>
#include <hip/hip_cooperative_groups.h>
#include <cstdio>
#include <cstdint>
namespace cg = cooperative_groups;
namespace pg8 {
#define PG8_LAS __attribute__((address_space(3)))
typedef unsigned short bf16_t;
typedef short bf16x8 __attribute__((ext_vector_type(8)));
typedef float f32x4 __attribute__((ext_vector_type(4)));
typedef unsigned u32x4 __attribute__((ext_vector_type(4)));
constexpr int BM = 256, BK = 64, HALF = 128, HTB = HALF * BK * 2  , STAGE_BYTES = 8 * HTB, NXCD = 8, WGM = 8;

__host__ __device__ __forceinline__ int lds_byte(int r, int c) { const int st = (r >> 4) * 2 + (c >> 5), rr = r & 15, cc = c & 31, ob = rr * 64 + cc * 2; return st * 1024 + (ob ^ (((ob >> 9) & 1) << 5)); }
__host__ __device__ __forceinline__ void stage_rc(int b, int& R, int& C) { const int st = b / 1024, sb = b % 1024, swz = sb ^ (((sb >> 9) & 1) << 5); R = (st >> 1) * 16 + swz / 64; C = (st & 1) * 32 + (swz % 64) / 2; }
__host__ __device__ __forceinline__ int perm32(int rho) { const int n = rho >> 4, i = rho & 15; return 8 * (i >> 2) + 4 * n + (i & 3); }

struct Unit { int pm, pn; };
struct Gemm { const bf16_t* A; const bf16_t* Bt; int M, N, K; };

struct StaticOrder {
    int nM, nN, nwg, G, c;
    __host__ __device__ void init(int M, int N, int G_, int c_) { nM = M / BM; nN = N / BM; nwg = nM * nN; G = G_; c = c_; }
    __host__ __device__ bool next(int i, Unit& u) const {
        const long L = (long)i * G + c; if (L >= nwg) return false;
        int wgid = (int)L; { const int q = nwg / NXCD, r = nwg % NXCD, xcd = wgid % NXCD, off = wgid / NXCD; wgid = (xcd < r ? xcd * (q + 1) : r * (q + 1) + (xcd - r) * q) + off; }
        const int nig = WGM * nN, gid = wgid / nig, fm = gid * WGM, gsz = (nM - fm) < WGM ? (nM - fm) : WGM;
        u.pm = fm + ((wgid % nig) % gsz); u.pn = (wgid % nig) / gsz; return true;
    }
    __device__ __forceinline__ void a_ready(const Unit&) const {}
    __device__ __forceinline__ void done(const Unit&) const {}
};

__device__ __forceinline__ unsigned cvt_pk_bf16(float lo, float hi) { unsigned r; asm volatile("v_cvt_pk_bf16_f32 %0, %1, %2" : "=v"(r) : "v"(lo), "v"(hi)); return r; }

struct EpiStoreBf16 {
    static constexpr bool PERM = true, AFTER_DRAIN = false;
    bf16_t* O; int ldc;
    __device__ __forceinline__ void operator()(const f32x4 (&acc)[2][2][4][2], const Unit& u, int wr, int wc, int fr, int fq) const {
        const int row0 = u.pm * BM + wr * 64 + fr, col0 = u.pn * BM + wc * 32 + 8 * fq;
#pragma unroll
        for (int ai = 0; ai < 2; ++ai)
#pragma unroll
            for (int m = 0; m < 4; ++m) { bf16_t* rowp = O + (size_t)(row0 + ai * HALF + m * 16) * ldc + col0;
#pragma unroll
                for (int bj = 0; bj < 2; ++bj) { const f32x4 v0 = acc[ai][bj][m][0], v1 = acc[ai][bj][m][1];
                    u32x4 w; w.x = cvt_pk_bf16(v0[0], v0[1]); w.y = cvt_pk_bf16(v0[2], v0[3]); w.z = cvt_pk_bf16(v1[0], v1[1]); w.w = cvt_pk_bf16(v1[2], v1[3]);
                    *(u32x4*)(rowp + bj * HALF) = w; } }
    }
};
struct EpiResid {
    static constexpr bool PERM = true, AFTER_DRAIN = false;
    const float* X; float* Out; const float* gate;
    __device__ __forceinline__ void operator()(const f32x4 (&acc)[2][2][4][2], const Unit& u, int wr, int wc, int fr, int fq) const {
        const int row0 = u.pm * BM + wr * 64 + fr, col0 = u.pn * BM + wc * 32 + 8 * fq;
        const float* gp = gate + (size_t)((u.pm * BM) >> 12) * 6144 + col0;
        f32x4 gv[2][2];
#pragma unroll
        for (int bj = 0; bj < 2; ++bj)
#pragma unroll
            for (int n = 0; n < 2; ++n) gv[bj][n] = *(const f32x4*)(gp + bj * HALF + 4 * n);
#pragma unroll
        for (int ai = 0; ai < 2; ++ai)
#pragma unroll
            for (int m = 0; m < 4; ++m) { const size_t ro = (size_t)(row0 + ai * HALF + m * 16) * 1024 + col0;
#pragma unroll
                for (int bj = 0; bj < 2; ++bj) {
                    const f32x4 x0 = *(const f32x4*)(X + ro + bj * HALF), x1 = *(const f32x4*)(X + ro + bj * HALF + 4);
                    const f32x4 o0 = x0 + gv[bj][0] * acc[ai][bj][m][0], o1 = x1 + gv[bj][1] * acc[ai][bj][m][1];
                    *(f32x4*)(Out + ro + bj * HALF) = o0; *(f32x4*)(Out + ro + bj * HALF + 4) = o1; } }
    }
};
struct EpiSwiGLU {
    static constexpr bool PERM = true, AFTER_DRAIN = false;
    bf16_t* O; int ldc;
    __device__ __forceinline__ void operator()(const f32x4 (&acc)[2][2][4][2], const Unit& u, int wr, int wc, int fr, int fq) const {
        const int row0 = u.pm * BM + wr * 64 + fr, col0 = u.pn * HALF + wc * 32 + 8 * fq;
#pragma unroll
        for (int ai = 0; ai < 2; ++ai)
#pragma unroll
            for (int m = 0; m < 4; ++m) { bf16_t* rowp = O + (size_t)(row0 + ai * HALF + m * 16) * ldc + col0;
                float a[8];
#pragma unroll
                for (int n = 0; n < 2; ++n)
#pragma unroll
                    for (int e = 0; e < 4; ++e) { const float g = acc[ai][0][m][n][e], up = acc[ai][1][m][n][e];
                        a[4 * n + e] = g * __builtin_amdgcn_rcpf(1.0f + __expf(-g)) * up; }
                u32x4 w; w.x = cvt_pk_bf16(a[0], a[1]); w.y = cvt_pk_bf16(a[2], a[3]); w.z = cvt_pk_bf16(a[4], a[5]); w.w = cvt_pk_bf16(a[6], a[7]);
                *(u32x4*)rowp = w; }
    }
};

template <class Epi, class Sched, bool ALIGN_EPI = false, bool SP2 = false>
__device__ __forceinline__ void gemm_phase(PG8_LAS unsigned char* lds, const Gemm g, const Sched& S, const Epi& E) {
    int tid_ = threadIdx.x; asm volatile("" : "+v"(tid_));
    const int tid = tid_, wid = __builtin_amdgcn_readfirstlane(tid >> 6), lane = tid & 63, wr = wid >> 2, wc = wid & 3, fr = lane & 15, fq = lane >> 4;
    const int K = g.K, nt = K / BK;
    unsigned voffA[2], voffB[2];
#pragma unroll
    for (int i = 0; i < 2; ++i) { int R, C; stage_rc(tid * 16 + i * 8192, R, C); const int Rb = Epi::PERM ? ((R & ~31) + perm32(R & 31)) : R;
        voffA[i] = (unsigned)(R * K + C) * 2u; voffB[i] = (unsigned)(Rb * K + C) * 2u; }
    const size_t kstep = (size_t)(BK * 2);
    const size_t hstep = (size_t)HALF * K * 2;
    const size_t tstep = 2 * hstep;
    const unsigned ldsw = (unsigned)wid * 1024u;
    const int aoff = lds_byte(wr * 64 + fr, fq * 8), boff = lds_byte(wc * 32 + fr, fq * 8);
#define PG8_SA(b, h) (((b) * 2 + (h)) * HTB)
#define PG8_SB(b, h) ((4 + (b) * 2 + (h)) * HTB)
#define PG8_STAGE(bufoff, gbase, voff) do { _Pragma("unroll") for (int _i = 0; _i < 2; ++_i) \
        __builtin_amdgcn_global_load_lds((const unsigned*)((const char*)(gbase) + (voff)[_i]), (PG8_LAS unsigned*)(lds + (bufoff) + ldsw + _i * 8192), 16, 0, 0); } while (0)
#define PG8_LDA(dst, b, h) do { _Pragma("unroll") for (int m = 0; m < 4; ++m) _Pragma("unroll") for (int k = 0; k < 2; ++k) dst[m][k] = *(const PG8_LAS bf16x8*)(lds + PG8_SA(b, h) + aoff + m * 2048 + k * 1024); } while (0)
#define PG8_LDB(dst, b, h) do { _Pragma("unroll") for (int n = 0; n < 2; ++n) _Pragma("unroll") for (int k = 0; k < 2; ++k) dst[n][k] = *(const PG8_LAS bf16x8*)(lds + PG8_SB(b, h) + boff + n * 2048 + k * 1024); } while (0)
#define PG8_MMA(ai, bj, At, Bt) do { __builtin_amdgcn_s_setprio(1); _Pragma("unroll") for (int m = 0; m < 4; ++m) _Pragma("unroll") for (int n = 0; n < 2; ++n) _Pragma("unroll") for (int k = 0; k < 2; ++k) \
        acc[ai][bj][m][n] = __builtin_amdgcn_mfma_f32_16x16x32_bf16(Bt[n][k], At[m][k], acc[ai][bj][m][n], 0, 0, 0); __builtin_amdgcn_s_setprio(0); } while (0)
#define PG8_WAIT_V(n) asm volatile("s_waitcnt vmcnt(" #n ")" ::: "memory")
#define PG8_WAIT_L(n) asm volatile("s_waitcnt lgkmcnt(" #n ")" ::: "memory")
#define PG8_BAR __builtin_amdgcn_s_barrier()
#define PG8_SCHED __builtin_amdgcn_sched_barrier(0)
    Unit cur, nxt; int ui = 0;
    if (!S.next(0, cur)) return;
    f32x4 acc[2][2][4][2];
#pragma unroll
    for (int a = 0; a < 2; ++a)
#pragma unroll
        for (int b = 0; b < 2; ++b)
#pragma unroll
            for (int m = 0; m < 4; ++m)
#pragma unroll
                for (int n = 0; n < 2; ++n) acc[a][b][m][n] = (f32x4){0.f, 0.f, 0.f, 0.f};
    bf16x8 At[4][2], B0[2][2], B1[2][2];
    const char* cA = (const char*)g.A + (size_t)cur.pm * tstep; const char* cB = (const char*)g.Bt + (size_t)cur.pn * tstep;
    S.a_ready(cur);
    if constexpr (SP2) {
        PG8_STAGE(PG8_SB(0, 0), cB, voffB); PG8_STAGE(PG8_SB(0, 1), cB + hstep, voffB); PG8_STAGE(PG8_SA(0, 0), cA, voffA); PG8_STAGE(PG8_SA(0, 1), cA + hstep, voffA);
        if (wr == 1) PG8_BAR;
        PG8_WAIT_V(2); PG8_BAR;
        PG8_STAGE(PG8_SB(1, 0), cB + kstep, voffB); PG8_STAGE(PG8_SA(1, 0), cA + kstep, voffA); PG8_STAGE(PG8_SB(1, 1), cB + hstep + kstep, voffB);
        PG8_WAIT_V(6); PG8_BAR;
    } else {
        PG8_STAGE(PG8_SB(0, 0), cB, voffB); PG8_STAGE(PG8_SA(0, 0), cA, voffA); PG8_STAGE(PG8_SB(0, 1), cB + hstep, voffB); PG8_STAGE(PG8_SA(0, 1), cA + hstep, voffA);
        if (wr == 1) PG8_BAR;
        PG8_WAIT_V(4); PG8_BAR;
        PG8_STAGE(PG8_SB(1, 0), cB + kstep, voffB); PG8_STAGE(PG8_SA(1, 0), cA + kstep, voffA); PG8_STAGE(PG8_SB(1, 1), cB + hstep + kstep, voffB);
        PG8_WAIT_V(6); PG8_BAR;
    }
    for (;;) {
        const bool has_next = S.next(ui + 1, nxt);
        const char* nA = has_next ? (const char*)g.A + (size_t)nxt.pm * tstep : cA; const char* nB = has_next ? (const char*)g.Bt + (size_t)nxt.pn * tstep : cB;
        for (int t = 0; t < nt; t += 2) {
            const bool last = (t == nt - 2);
            const char* a1 = cA + (size_t)(t + 1) * kstep;
            const char* a2 = last ? nA : cA + (size_t)(t + 2) * kstep; const char* b2 = last ? nB : cB + (size_t)(t + 2) * kstep;
            const char* a3 = a2 + kstep; const char* b3 = b2 + kstep;
            if (last && has_next) S.a_ready(nxt);
            if constexpr (SP2) {
            PG8_LDB(B0, 0, 0); PG8_LDB(B1, 0, 1); PG8_SCHED; PG8_LDA(At, 0, 0); PG8_STAGE(PG8_SA(1, 1), a1 + hstep, voffA);
            PG8_WAIT_V(8); PG8_WAIT_L(0); PG8_BAR; PG8_MMA(0, 0, At, B0); PG8_MMA(0, 1, At, B1); PG8_BAR; PG8_SCHED;
            PG8_LDA(At, 0, 1); PG8_STAGE(PG8_SB(0, 0), b2, voffB); PG8_STAGE(PG8_SB(0, 1), b2 + hstep, voffB); PG8_STAGE(PG8_SA(0, 0), a2, voffA);
            PG8_WAIT_V(8); PG8_WAIT_L(0); PG8_BAR; PG8_MMA(1, 0, At, B0); PG8_MMA(1, 1, At, B1); PG8_BAR; PG8_SCHED;
            PG8_LDB(B0, 1, 0); PG8_LDB(B1, 1, 1); PG8_SCHED; PG8_LDA(At, 1, 0); PG8_STAGE(PG8_SA(0, 1), a2 + hstep, voffA);
            PG8_WAIT_V(8); PG8_WAIT_L(0); PG8_BAR; PG8_MMA(0, 0, At, B0); PG8_MMA(0, 1, At, B1); PG8_BAR; PG8_SCHED;
            PG8_LDA(At, 1, 1); PG8_STAGE(PG8_SB(1, 0), b3, voffB); PG8_STAGE(PG8_SB(1, 1), b3 + hstep, voffB); PG8_STAGE(PG8_SA(1, 0), a3, voffA);
            PG8_WAIT_V(8); PG8_WAIT_L(0); PG8_BAR; PG8_MMA(1, 0, At, B0); PG8_MMA(1, 1, At, B1); PG8_BAR; PG8_SCHED;
            } else {
            PG8_LDB(B0, 0, 0); PG8_SCHED; PG8_LDA(At, 0, 0); PG8_STAGE(PG8_SA(1, 1), a1 + hstep, voffA);
            PG8_WAIT_L(8); PG8_BAR; PG8_WAIT_L(0); PG8_MMA(0, 0, At, B0); PG8_BAR; PG8_SCHED;
            PG8_LDB(B1, 0, 1); PG8_STAGE(PG8_SB(0, 0), b2, voffB);
            PG8_BAR; PG8_WAIT_L(0); PG8_MMA(0, 1, At, B1); PG8_BAR;
            PG8_LDA(At, 0, 1); PG8_STAGE(PG8_SA(0, 0), a2, voffA);
            PG8_BAR; PG8_WAIT_L(0); PG8_MMA(1, 0, At, B0); PG8_BAR; PG8_SCHED;
            PG8_STAGE(PG8_SB(0, 1), b2 + hstep, voffB);
            PG8_WAIT_V(6); PG8_BAR; PG8_MMA(1, 1, At, B1); PG8_BAR;
            PG8_LDB(B0, 1, 0); PG8_SCHED; PG8_LDA(At, 1, 0); PG8_STAGE(PG8_SA(0, 1), a2 + hstep, voffA);
            PG8_WAIT_L(8); PG8_BAR; PG8_WAIT_L(0); PG8_MMA(0, 0, At, B0); PG8_BAR; PG8_SCHED;
            PG8_LDB(B1, 1, 1); PG8_STAGE(PG8_SB(1, 0), b3, voffB);
            PG8_BAR; PG8_WAIT_L(0); PG8_MMA(0, 1, At, B1); PG8_BAR;
            PG8_LDA(At, 1, 1); PG8_STAGE(PG8_SA(1, 0), a3, voffA);
            PG8_BAR; PG8_WAIT_L(0); PG8_MMA(1, 0, At, B0); PG8_BAR; PG8_SCHED;
            PG8_STAGE(PG8_SB(1, 1), b3 + hstep, voffB);
            PG8_WAIT_V(6); PG8_BAR; PG8_MMA(1, 1, At, B1); PG8_BAR;
            }
        }
        if constexpr (ALIGN_EPI) { if (wr == 0) PG8_BAR; }
        if constexpr (!Epi::AFTER_DRAIN) { E(acc, cur, wr, wc, fr, fq); S.done(cur); }
        if (!has_next) break;
#pragma unroll
        for (int a = 0; a < 2; ++a)
#pragma unroll
            for (int b = 0; b < 2; ++b)
#pragma unroll
                for (int m = 0; m < 4; ++m)
#pragma unroll
                    for (int n = 0; n < 2; ++n) acc[a][b][m][n] = (f32x4){0.f, 0.f, 0.f, 0.f};
        cur = nxt; cA = nA; cB = nB; ++ui;
        if constexpr (ALIGN_EPI) { if (wr == 1) PG8_BAR; }
    }
    PG8_WAIT_V(0);
    if constexpr (!ALIGN_EPI) { if (wr == 0) PG8_BAR; }
    PG8_BAR;
    if constexpr (Epi::AFTER_DRAIN) { E.fused(acc, cur, wr, wc, fr, fq, lds, wid, lane); S.done(cur); }
#undef PG8_SA
#undef PG8_SB
#undef PG8_STAGE
#undef PG8_LDA
#undef PG8_LDB
#undef PG8_MMA
#undef PG8_WAIT_V
#undef PG8_WAIT_L
#undef PG8_BAR
#undef PG8_SCHED
}
}

typedef unsigned short bf16_t;
typedef short bf16x8 __attribute__((ext_vector_type(8)));
typedef short s16x4 __attribute__((ext_vector_type(4)));
typedef float f32x4 __attribute__((ext_vector_type(4)));
typedef float f32x16 __attribute__((ext_vector_type(16)));
typedef unsigned u32x4 __attribute__((ext_vector_type(4)));
typedef unsigned u32x2 __attribute__((ext_vector_type(2)));
#define DI __device__ __forceinline__

constexpr int M_TOK = 32768, DM = 1024, SEQ = 4096, NB = 8, DFF = 2816, NMOD = 6144;
constexpr float EPS = 1e-6f;
constexpr int NTHREADS = 512;

constexpr size_t MiB = 1u << 20;
constexpr size_t WS_MOD = 0;
constexpr size_t WS_COS = 1 * MiB, WS_SIN = 5 * MiB;
constexpr size_t WS_WIN = 16 * MiB;
constexpr size_t WS_WQ = 18 * MiB;
constexpr size_t WS_WMIX = 19 * MiB;
constexpr size_t WS_WGU = 21 * MiB;
constexpr size_t WS_WDN = 32 * MiB;
constexpr size_t WS_H = 64 * MiB;
constexpr size_t WS_ACT = 128 * MiB;
constexpr size_t WS_PROJ = 128 * MiB;
constexpr size_t WS_AMIX = 192 * MiB;
constexpr size_t WS_QP = 256 * MiB;
constexpr size_t WS_CQ = 304 * MiB;
constexpr size_t WS_KB = 320 * MiB;
constexpr size_t WS_END = 332 * MiB;

constexpr int LDS_BYTES = 135168;

struct Params {
    const float* x; const float* c; const int* pos; const float* w_ada; const float* b_ada; const float* g_mix; const float* w_in;
    const float* g_q; const float* g_kv; const float* w_uq; const float* w_uk; const float* w_uv; const float* w_pool; const float* pool_scale;
    const float* w_o; const float* g_ffn; const float* w_gate; const float* w_up; const float* w_down; const float* g_final;
    float* out; unsigned char* ws;
};

DI float bf2f(unsigned short h) { return __uint_as_float((unsigned)h << 16); }
DI unsigned cvtpk(float lo, float hi) { unsigned r; asm volatile("v_cvt_pk_bf16_f32 %0, %1, %2" : "=v"(r) : "v"(lo), "v"(hi)); return r; }
DI int otid() { int t = threadIdx.x; asm volatile("" : "+v"(t)); return t; }
DI float wave_sum(float v) {
#pragma unroll
    for (int o = 32; o >= 1; o >>= 1) v += __shfl_xor(v, o);
    return v;
}

constexpr int N_FMIX = 128, N_ADA = 192, N_FQ = 384, N_TR_IN = 256, N_TR_G = 704, N_TR_U = 704, N_TR_D = 704;
constexpr int N_ITEMS = N_FMIX + N_ADA + N_FQ + N_TR_IN + N_TR_G + N_TR_U + N_TR_D;

DI void p0_fold_mix(const Params& p, int item, float* lds) {
    const int tid = otid(), blk = item >> 4, nt = item & 15;
    float* L = lds;
    float* Wo = lds + 128 * 132;
    for (int i = tid; i < 128 * 32; i += NTHREADS) {
        const int cc = i >> 5, v4 = (i & 31) * 4;
        f32x4 v;
        if (blk < 4) v = *(const f32x4*)(p.w_uv + (size_t)(cc * 4 + blk) * 128 + v4);
        else { const int g = blk - 4; v = *(const f32x4*)(p.w_pool + (size_t)(g * 128 + cc) * 128 + v4) * *(const f32x4*)(p.pool_scale + g * 128 + v4); }
        *(f32x4*)(L + cc * 132 + v4) = v;
    }
    for (int i = tid; i < 128 * 16; i += NTHREADS) {
        const int v = i >> 4, n4 = (i & 15) * 4;
        *(f32x4*)(Wo + v * 64 + n4) = *(const f32x4*)(p.w_o + (size_t)(blk * 128 + v) * 1024 + nt * 64 + n4);
    }
    __syncthreads();
    const int n = tid & 63, ccg = tid >> 6;
    float acc[16];
#pragma unroll
    for (int i = 0; i < 16; ++i) acc[i] = 0.f;
    for (int v4 = 0; v4 < 128; v4 += 4) {
        const float w0 = Wo[(v4 + 0) * 64 + n], w1 = Wo[(v4 + 1) * 64 + n], w2 = Wo[(v4 + 2) * 64 + n], w3 = Wo[(v4 + 3) * 64 + n];
#pragma unroll
        for (int i = 0; i < 16; ++i) { const f32x4 l = *(const f32x4*)(L + (ccg * 16 + i) * 132 + v4);
            acc[i] = fmaf(l[0], w0, acc[i]); acc[i] = fmaf(l[1], w1, acc[i]); acc[i] = fmaf(l[2], w2, acc[i]); acc[i] = fmaf(l[3], w3, acc[i]); }
    }
    bf16_t* dst = (bf16_t*)(p.ws + WS_WMIX) + (size_t)(nt * 64 + n) * 1024 + blk * 128 + ccg * 16;
    u32x4 w0, w1;
    w0.x = cvtpk(acc[0], acc[1]); w0.y = cvtpk(acc[2], acc[3]); w0.z = cvtpk(acc[4], acc[5]); w0.w = cvtpk(acc[6], acc[7]);
    w1.x = cvtpk(acc[8], acc[9]); w1.y = cvtpk(acc[10], acc[11]); w1.z = cvtpk(acc[12], acc[13]); w1.w = cvtpk(acc[14], acc[15]);
    *(u32x4*)dst = w0; *(u32x4*)(dst + 8) = w1;
    __syncthreads();
}

DI void p0_ada(const Params& p, int item, float* lds) {
    const int tid = otid(), n0 = item * 32, col = tid & 31, kg = tid >> 5;
    float* cact = lds;
    float* red = lds + 8192;
    for (int i = tid; i < 8192; i += NTHREADS) { const float v = p.c[i]; cact[i] = v / (1.0f + __expf(-v)); }
    __syncthreads();
    float acc[8];
#pragma unroll
    for (int b = 0; b < 8; ++b) acc[b] = 0.f;
    const float* wp = p.w_ada + (size_t)(kg * 64) * NMOD + n0 + col;
#pragma unroll 8
    for (int kk = 0; kk < 64; ++kk) {
        const float w = wp[(size_t)kk * NMOD];
#pragma unroll
        for (int b = 0; b < 8; ++b) acc[b] = fmaf(cact[b * 1024 + kg * 64 + kk], w, acc[b]);
    }
#pragma unroll
    for (int b = 0; b < 8; ++b) red[(kg * 8 + b) * 32 + col] = acc[b];
    __syncthreads();
    if (tid < 256) {
        const int b = tid >> 5; float s = 0.f;
#pragma unroll
        for (int g = 0; g < 16; ++g) s += red[(g * 8 + b) * 32 + col];
        ((float*)(p.ws + WS_MOD))[b * NMOD + n0 + col] = s + p.b_ada[n0 + col];
    }
    __syncthreads();
}

DI void p0_fold_q(const Params& p, int item) {
    const int tid = otid(), n = item * 2 + (tid >> 8), r = tid & 255;
    float acc = 0.f;
    if (n < 512) {
        const int h = n >> 7, cc = n & 127;
        const float* a = p.w_uq + (size_t)(r * 4 + h) * 192; const float* b = p.w_uk + (size_t)(cc * 4 + h) * 128;
#pragma unroll 8
        for (int d = 0; d < 128; d += 4) { const f32x4 x = *(const f32x4*)(a + d), y = *(const f32x4*)(b + d);
            acc = fmaf(x[0], y[0], acc); acc = fmaf(x[1], y[1], acc); acc = fmaf(x[2], y[2], acc); acc = fmaf(x[3], y[3], acc); }
    } else {
        const int h = (n - 512) >> 6, j = (n - 512) & 63;
        acc = p.w_uq[(size_t)(r * 4 + h) * 192 + 128 + j];
    }
    acc *= p.g_q[r];
    ((bf16_t*)(p.ws + WS_WQ))[(size_t)n * 256 + r] = (bf16_t)(cvtpk(acc, 0.f) & 0xffffu);
}

DI void p0_transpose(const float* src, int ld_src, bf16_t* dst, int ld_dst, int kt, int ntile, int kind, float* lds) {
    const int tid = otid(), k0 = kt * 64, n0 = ntile * 64;
    float* tile = lds;
    const bool zero = (kind == 0 && n0 >= 960);
#pragma unroll
    for (int i = 0; i < 2; ++i) {
        const int kk = (tid >> 4) + 32 * i, nn4 = (tid & 15) * 4;
        f32x4 v = (f32x4){0.f, 0.f, 0.f, 0.f};
        if (!zero) v = *(const f32x4*)(src + (size_t)(k0 + kk) * ld_src + n0 + nn4);
        tile[kk * 65 + nn4 + 0] = v[0]; tile[kk * 65 + nn4 + 1] = v[1]; tile[kk * 65 + nn4 + 2] = v[2]; tile[kk * 65 + nn4 + 3] = v[3];
    }
    __syncthreads();
    const int nn = tid >> 3, ks = (tid & 7) * 8, n = n0 + nn;
    int drow = n;
    if (kind == 1) drow = (n >> 7) * 256 + (n & 127);
    else if (kind == 2) drow = (n >> 7) * 256 + 128 + (n & 127);
    u32x4 w;
    w.x = cvtpk(tile[(ks + 0) * 65 + nn], tile[(ks + 1) * 65 + nn]); w.y = cvtpk(tile[(ks + 2) * 65 + nn], tile[(ks + 3) * 65 + nn]);
    w.z = cvtpk(tile[(ks + 4) * 65 + nn], tile[(ks + 5) * 65 + nn]); w.w = cvtpk(tile[(ks + 6) * 65 + nn], tile[(ks + 7) * 65 + nn]);
    *(u32x4*)(dst + (size_t)drow * ld_dst + k0 + ks) = w;
    __syncthreads();
}

DI void p0_prep(const Params& p, float* lds) {
    for (int it = blockIdx.x; it < N_ITEMS; it += gridDim.x) {
        int i = it;
        if (i < N_FMIX) { p0_fold_mix(p, i, lds); continue; } i -= N_FMIX;
        if (i < N_ADA) { p0_ada(p, i, lds); continue; } i -= N_ADA;
        if (i < N_FQ) { p0_fold_q(p, i); continue; } i -= N_FQ;
        if (i < N_TR_IN) { p0_transpose(p.w_in, 960, (bf16_t*)(p.ws + WS_WIN), 1024, i >> 4, i & 15, 0, lds); continue; } i -= N_TR_IN;
        if (i < N_TR_G) { p0_transpose(p.w_gate, DFF, (bf16_t*)(p.ws + WS_WGU), 1024, i / 44, i % 44, 1, lds); continue; } i -= N_TR_G;
        if (i < N_TR_U) { p0_transpose(p.w_up, DFF, (bf16_t*)(p.ws + WS_WGU), 1024, i / 44, i % 44, 2, lds); continue; } i -= N_TR_U;
        p0_transpose(p.w_down, DM, (bf16_t*)(p.ws + WS_WDN), DFF, i >> 4, i & 15, 3, lds);
    }
}

DI void norm_mod_phase(const float* X, const float* g, const float* mod, int off_sh, int off_sc, bf16_t* H) {
    const int tid = otid(), lane = tid & 63, gw = blockIdx.x * 8 + (tid >> 6), nw = gridDim.x * 8;
    for (int row = gw; row < M_TOK; row += nw) {
        const int b = row >> 12;
        const float* xr = X + (size_t)row * DM;
        f32x4 v[4]; float ss = 0.f;
#pragma unroll
        for (int i = 0; i < 4; ++i) { v[i] = *(const f32x4*)(xr + i * 256 + lane * 4); ss += v[i][0] * v[i][0] + v[i][1] * v[i][1] + v[i][2] * v[i][2] + v[i][3] * v[i][3]; }
        ss = wave_sum(ss);
        const float rstd = 1.0f / sqrtf(ss * (1.0f / DM) + EPS);
#pragma unroll
        for (int i = 0; i < 4; ++i) {
            const int col = i * 256 + lane * 4;
            const f32x4 gg = *(const f32x4*)(g + col), sc = *(const f32x4*)(mod + b * NMOD + off_sc + col), sh = *(const f32x4*)(mod + b * NMOD + off_sh + col);
            float y[4];
#pragma unroll
            for (int e = 0; e < 4; ++e) y[e] = v[i][e] * rstd * gg[e] * (1.0f + sc[e]) + sh[e];
            u32x2 w; w.x = cvtpk(y[0], y[1]); w.y = cvtpk(y[2], y[3]);
            *(u32x2*)(H + (size_t)row * DM + col) = w;
        }
    }
}

DI void post_proj_phase(const Params& p) {
    const bf16_t* proj = (const bf16_t*)(p.ws + WS_PROJ);
    bf16_t* cq = (bf16_t*)(p.ws + WS_CQ); bf16_t* kb = (bf16_t*)(p.ws + WS_KB); bf16_t* amix = (bf16_t*)(p.ws + WS_AMIX);
    float* cosT = (float*)(p.ws + WS_COS); float* sinT = (float*)(p.ws + WS_SIN);
    const int tid = otid(), lane = tid & 63, gw = blockIdx.x * 8 + (tid >> 6), nw = gridDim.x * 8;
    const float freq = (float)exp2(-(double)(lane & 31) * (13.287712379549449 / 32.0));
    for (int t = gw; t < M_TOK; t += nw) {
        const int s = t & (SEQ - 1);
        const bf16_t* row = proj + (size_t)t * 1024;
        { const u32x2 w = *(const u32x2*)(row + lane * 4);
          const float a0 = __uint_as_float(w.x << 16), a1 = __uint_as_float(w.x & 0xffff0000u), a2 = __uint_as_float(w.y << 16), a3 = __uint_as_float(w.y & 0xffff0000u);
          const float ss = wave_sum(a0 * a0 + a1 * a1 + a2 * a2 + a3 * a3);
          const float rstd = 1.0f / sqrtf(ss * (1.0f / 256.0f) + EPS);
          u32x2 o; o.x = cvtpk(a0 * rstd, a1 * rstd); o.y = cvtpk(a2 * rstd, a3 * rstd);
          *(u32x2*)(cq + (size_t)t * 256 + lane * 4) = o; }
        { const unsigned w = *(const unsigned*)(row + 256 + lane * 2);
          const float a0 = __uint_as_float(w << 16), a1 = __uint_as_float(w & 0xffff0000u);
          const float ss = wave_sum(a0 * a0 + a1 * a1);
          const float rstd = 1.0f / sqrtf(ss * (1.0f / 128.0f) + EPS);
          *(unsigned*)(kb + (size_t)t * 192 + lane * 2) = cvtpk(a0 * rstd * p.g_kv[lane * 2], a1 * rstd * p.g_kv[lane * 2 + 1]); }
        if (lane < 32) {
            const float x1 = bf2f(row[384 + lane]), x2 = bf2f(row[384 + 32 + lane]);
            const float ang = (float)p.pos[t] * freq;
            const float cs = cosf(ang), sn = sinf(ang);
            cosT[(size_t)t * 32 + lane] = cs; sinT[(size_t)t * 32 + lane] = sn;
            kb[(size_t)t * 192 + 128 + lane] = (bf16_t)(cvtpk(x1 * cs - x2 * sn, 0.f) & 0xffffu);
            kb[(size_t)t * 192 + 160 + lane] = (bf16_t)(cvtpk(x1 * sn + x2 * cs, 0.f) & 0xffffu);
        }
        { const int pc = lane * 8, w = 2 << (lane >> 4), cnt = (s + 1 < w) ? (s + 1) : w;
          float sum[8], self[8];
#pragma unroll
          for (int e = 0; e < 8; ++e) sum[e] = 0.f;
#pragma unroll
          for (int i = 0; i < 16; ++i) {
              if (i < cnt) {
                  const u32x4 q = *(const u32x4*)(row - (size_t)i * 1024 + 448 + pc);
                  float f[8];
                  f[0] = __uint_as_float(q.x << 16); f[1] = __uint_as_float(q.x & 0xffff0000u); f[2] = __uint_as_float(q.y << 16); f[3] = __uint_as_float(q.y & 0xffff0000u);
                  f[4] = __uint_as_float(q.z << 16); f[5] = __uint_as_float(q.z & 0xffff0000u); f[6] = __uint_as_float(q.w << 16); f[7] = __uint_as_float(q.w & 0xffff0000u);
#pragma unroll
                  for (int e = 0; e < 8; ++e) { sum[e] += f[e]; if (i == 0) self[e] = f[e]; }
              }
          }
          const float inv = 1.0f / (float)cnt;
          u32x4 o;
          o.x = cvtpk(sum[0] * inv - self[0], sum[1] * inv - self[1]); o.y = cvtpk(sum[2] * inv - self[2], sum[3] * inv - self[3]);
          o.z = cvtpk(sum[4] * inv - self[4], sum[5] * inv - self[5]); o.w = cvtpk(sum[6] * inv - self[6], sum[7] * inv - self[7]);
          *(u32x4*)(amix + (size_t)t * 1024 + 512 + pc) = o; }
    }
}

namespace att {
constexpr float SCALE = 0.07216878364870322f;
constexpr float THR = 8.f;
constexpr int SHM_V = 64 * 128 * 2, SHM_K = 64 * 192 * 2;
constexpr int OFF_V = 0, OFF_K = 2 * SHM_V, OFF_WS = OFF_K + 2 * SHM_K, ATT_LDS = OFF_WS + 8 * 64 * 4;
#define KSWZ(row, colB) ((row) * 384 + ((colB) ^ (((row) & 7) << 4)))
#define SBAR() __builtin_amdgcn_sched_barrier(0)
DI int crow(int r, int hi) { return (r & 3) + 8 * (r >> 2) + 4 * hi; }

DI void partialSM(f32x16& p0, f32x16& p1, float& m_reg, float& mn, float& alpha) {
    constexpr float C = SCALE * 1.4426950408889634f;
    float pmax = p0[0];
#pragma unroll
    for (int r = 1; r < 16; ++r) pmax = fmaxf(pmax, p0[r]);
#pragma unroll
    for (int r = 0; r < 16; ++r) pmax = fmaxf(pmax, p1[r]);
    { auto rr = __builtin_amdgcn_permlane32_swap(__float_as_uint(pmax), __float_as_uint(pmax), false, false);
      pmax = fmaxf(__uint_as_float(rr[0]), __uint_as_float(rr[1])); }
    if (__builtin_expect(__all(pmax - m_reg <= THR / SCALE), 1)) { mn = m_reg; alpha = 1.f; }
    else { mn = fmaxf(m_reg, pmax); alpha = __builtin_amdgcn_exp2f((m_reg - mn) * C); m_reg = mn; }
    const float mnC = -mn * C;
#pragma unroll
    for (int r = 0; r < 16; ++r) p0[r] = fmaf(p0[r], C, mnC);
#pragma unroll
    for (int r = 0; r < 16; ++r) p1[r] = fmaf(p1[r], C, mnC);
#pragma unroll
    for (int r = 0; r < 16; ++r) p0[r] = __builtin_amdgcn_exp2f(p0[r]);
}
DI void finishSM(f32x16& p0, f32x16& p1, float alpha, float& l_reg, bf16x8& pa0, bf16x8& pa1, bf16x8& pa2, bf16x8& pa3) {
#pragma unroll
    for (int r = 0; r < 16; ++r) p1[r] = __builtin_amdgcn_exp2f(p1[r]);
    float ps = 0;
#pragma unroll
    for (int r = 0; r < 16; ++r) ps += p0[r];
#pragma unroll
    for (int r = 0; r < 16; ++r) ps += p1[r];
    { auto rr = __builtin_amdgcn_permlane32_swap(__float_as_uint(ps), __float_as_uint(ps), false, false);
      ps = __uint_as_float(rr[0]) + __uint_as_float(rr[1]); }
    l_reg = l_reg * alpha + ps;
#define PK4(P, BASE, OUT) do { unsigned a0 = cvtpk(P[BASE + 0], P[BASE + 1]), a1 = cvtpk(P[BASE + 2], P[BASE + 3]);   \
    unsigned b0 = cvtpk(P[BASE + 4], P[BASE + 5]), b1 = cvtpk(P[BASE + 6], P[BASE + 7]);                              \
    auto r0 = __builtin_amdgcn_permlane32_swap(a0, b0, false, false); auto r1 = __builtin_amdgcn_permlane32_swap(a1, b1, false, false); \
    u32x4 w = {r0[0], r1[0], r0[1], r1[1]}; OUT = __builtin_bit_cast(bf16x8, w); } while (0)
    PK4(p0, 0, pa0); PK4(p0, 8, pa1); PK4(p1, 0, pa2); PK4(p1, 8, pa3);
#undef PK4
}
DI void qkt(f32x16& p0, f32x16& p1, const char* Ks, const bf16x8* qr, int r32, int hi) {
#pragma unroll
    for (int r = 0; r < 16; ++r) { p0[r] = 0.f; p1[r] = 0.f; }
    const int sw = (r32 & 7) << 4, rb = r32 * 384;
    int o4[4];
#pragma unroll
    for (int q = 0; q < 4; ++q) o4[q] = rb + ((q * 32 + hi * 16) ^ sw);
#pragma unroll
    for (int d0 = 0; d0 < 12; ++d0) {
        const bf16x8 b0 = *reinterpret_cast<const bf16x8*>(Ks + o4[d0 & 3] + (d0 >> 2) * 128);
        const bf16x8 b1 = *reinterpret_cast<const bf16x8*>(Ks + o4[d0 & 3] + (d0 >> 2) * 128 + 32 * 384);
        p0 = __builtin_amdgcn_mfma_f32_32x32x16_bf16(b0, qr[d0], p0, 0, 0, 0);
        p1 = __builtin_amdgcn_mfma_f32_32x32x16_bf16(b1, qr[d0], p1, 0, 0, 0);
        if ((d0 & 3) == 3) SBAR(); }
}
DI int v_st(int k, int c) { const int kk = (k & ~0xC) | ((k & 4) << 1) | ((k & 8) >> 1); return ((kk >> 3) * 4 + (c >> 5)) * 512 + ((kk & 7) * 32 + (c & 31)) * 2; }
DI int v_rd_base(int lane) { return ((lane & 3) << 3) | (((lane >> 2) & 3) << 6) | (((lane >> 4) & 1) << 5) | (((lane >> 5) & 1) << 8); }
constexpr int v_rd_off(int d0, int ks, int half) { return d0 * 512 + ks * 4096 + half * 2048; }
template <int OFF> DI s16x4 tr_read(int vb) {
    s16x4 r; asm volatile("ds_read_b64_tr_b16 %0, %1 offset:%2" : "=&v"(r) : "v"(vb), "i"(OFF) : "memory"); return r;
}
template <int D0> DI void pv_one(f32x16& od, int vb, bf16x8 pa0, bf16x8 pa1, bf16x8 pa2, bf16x8 pa3) {
    const s16x4 l0 = tr_read<v_rd_off(D0, 0, 0)>(vb), h0 = tr_read<v_rd_off(D0, 0, 1)>(vb), l1 = tr_read<v_rd_off(D0, 1, 0)>(vb), h1 = tr_read<v_rd_off(D0, 1, 1)>(vb);
    const s16x4 l2 = tr_read<v_rd_off(D0, 2, 0)>(vb), h2 = tr_read<v_rd_off(D0, 2, 1)>(vb), l3 = tr_read<v_rd_off(D0, 3, 0)>(vb), h3 = tr_read<v_rd_off(D0, 3, 1)>(vb);
    asm volatile("s_waitcnt lgkmcnt(0)" ::: "memory"); SBAR();
#define PK(L, H) (bf16x8){L[0], L[1], L[2], L[3], H[0], H[1], H[2], H[3]}
    od = __builtin_amdgcn_mfma_f32_32x32x16_bf16(pa0, PK(l0, h0), od, 0, 0, 0);
    od = __builtin_amdgcn_mfma_f32_32x32x16_bf16(pa1, PK(l1, h1), od, 0, 0, 0);
    od = __builtin_amdgcn_mfma_f32_32x32x16_bf16(pa2, PK(l2, h2), od, 0, 0, 0);
    od = __builtin_amdgcn_mfma_f32_32x32x16_bf16(pa3, PK(l3, h3), od, 0, 0, 0);
#undef PK
}

DI void attn_unit(int b, int c, const bf16_t* __restrict__ qp, const bf16_t* __restrict__ Kb, const float* __restrict__ cosT, const float* __restrict__ sinT,
                  bf16_t* __restrict__ amix, char* lds) {
    int tid = threadIdx.x; asm volatile("" : "+v"(tid));
    const int wid = __builtin_amdgcn_readfirstlane(tid >> 6), lane = tid & 63, r32 = lane & 31, hi = lane >> 5, hq = wid >> 1;
    char* V_lds = lds + OFF_V; char* K_lds = lds + OFF_K;
    float* ws = (float*)(lds + OFF_WS) + wid * 64; float* li_l = ws; float* al_l = ws + 32;
    const int tok0 = b * SEQ + c * 64 + (wid & 1) * 32, tok = tok0 + r32;
    bf16x8 qr[12];
    const bf16_t* qrow = qp + (size_t)tok * 768;
#pragma unroll
    for (int d0 = 0; d0 < 8; ++d0) qr[d0] = *(const bf16x8*)(qrow + hq * 128 + d0 * 16 + hi * 8);
#pragma unroll
    for (int dd = 0; dd < 2; ++dd) {
        const int j0 = dd * 16 + hi * 8;
        const bf16x8 x1 = *(const bf16x8*)(qrow + 512 + hq * 64 + j0), x2 = *(const bf16x8*)(qrow + 512 + hq * 64 + 32 + j0);
        const f32x4 c0 = *(const f32x4*)(cosT + (size_t)tok * 32 + j0), c1 = *(const f32x4*)(cosT + (size_t)tok * 32 + j0 + 4);
        const f32x4 s0 = *(const f32x4*)(sinT + (size_t)tok * 32 + j0), s1 = *(const f32x4*)(sinT + (size_t)tok * 32 + j0 + 4);
        float o1[8], o2[8];
#pragma unroll
        for (int e = 0; e < 8; ++e) { const float a = bf2f((unsigned short)x1[e]), bb = bf2f((unsigned short)x2[e]);
            const float cs = e < 4 ? c0[e & 3] : c1[e & 3], sn = e < 4 ? s0[e & 3] : s1[e & 3];
            o1[e] = a * cs - bb * sn; o2[e] = a * sn + bb * cs; }
        u32x4 w1 = {cvtpk(o1[0], o1[1]), cvtpk(o1[2], o1[3]), cvtpk(o1[4], o1[5]), cvtpk(o1[6], o1[7])};
        u32x4 w2 = {cvtpk(o2[0], o2[1]), cvtpk(o2[2], o2[3]), cvtpk(o2[4], o2[5]), cvtpk(o2[6], o2[7])};
        qr[8 + dd] = __builtin_bit_cast(bf16x8, w1); qr[10 + dd] = __builtin_bit_cast(bf16x8, w2);
    }
    int kst[3], vst[3];
#pragma unroll
    for (int i = 0; i < 3; ++i) { const int id = tid + 512 * i, row = id / 24, ch = id - row * 24;
        kst[i] = KSWZ(row, ch * 16); vst[i] = ch < 16 ? v_st(row, ch * 8) : -1; }
    const char* Kg = (const char*)(Kb + (size_t)b * SEQ * 192);
    const int NT = c + 1;
    bf16x8 st[3];
#define SLOAD(j) do { _Pragma("unroll") for (int i_ = 0; i_ < 3; ++i_) st[i_] = *(const bf16x8*)(Kg + (size_t)(j) * SHM_K + (size_t)(tid + 512 * i_) * 16); } while (0)
#define SWRITE(bf) do { _Pragma("unroll") for (int i_ = 0; i_ < 3; ++i_) { *(bf16x8*)(K_lds + (bf) * SHM_K + kst[i_]) = st[i_]; \
        if (vst[i_] >= 0) *(bf16x8*)(V_lds + (bf) * SHM_V + vst[i_]) = st[i_]; } } while (0)
    float m_reg = -1e30f, l_reg = 0.f;
    f32x16 o[4];
#pragma unroll
    for (int d = 0; d < 4; ++d)
#pragma unroll
        for (int r = 0; r < 16; ++r) o[d][r] = 0.f;
    const int vb0 = (int)(uintptr_t)V_lds + v_rd_base(lane);
    SLOAD(0); SWRITE(0);
    if (NT > 1) SLOAD(1);
    for (int j = 0; j < NT; ++j) {
        __syncthreads();
        const int cur = j & 1;
        if (j + 1 < NT) { SWRITE(cur ^ 1); if (j + 2 < NT) SLOAD(j + 2); }
        f32x16 p0, p1; float mn, alpha; bf16x8 pa0, pa1, pa2, pa3;
        qkt(p0, p1, K_lds + cur * SHM_K, qr, r32, hi);
        partialSM(p0, p1, m_reg, mn, alpha);
        if (__any(alpha < 1.f)) {
            if (hi == 0) al_l[r32] = alpha;
            asm volatile("s_waitcnt lgkmcnt(0)" ::: "memory");
#pragma unroll
            for (int d = 0; d < 4; ++d)
#pragma unroll
                for (int r = 0; r < 16; ++r) o[d][r] *= al_l[crow(r, hi)];
        }
        finishSM(p0, p1, alpha, l_reg, pa0, pa1, pa2, pa3);
        const int vb = vb0 + cur * SHM_V;
        pv_one<0>(o[0], vb, pa0, pa1, pa2, pa3); pv_one<1>(o[1], vb, pa0, pa1, pa2, pa3); pv_one<2>(o[2], vb, pa0, pa1, pa2, pa3); pv_one<3>(o[3], vb, pa0, pa1, pa2, pa3);
    }
    if (hi == 0) li_l[r32] = l_reg;
    asm volatile("s_waitcnt lgkmcnt(0)" ::: "memory");
    int tid2 = threadIdx.x; asm volatile("" : "+v"(tid2));
    bf16_t* orow = amix + (size_t)(b * SEQ + c * 64 + ((tid2 >> 6) & 1) * 32) * 1024 + (tid2 >> 7) * 128 + (tid2 & 31);
#pragma unroll
    for (int r = 0; r < 16; ++r) { const int qq = crow(r, hi); const float rl = __builtin_amdgcn_rcpf(li_l[qq]);
#pragma unroll
        for (int d0 = 0; d0 < 4; ++d0) orow[(size_t)qq * 1024 + d0 * 32] = (bf16_t)(cvtpk(o[d0][r] * rl, 0.f) & 0xffffu); }
    __syncthreads();
#undef SLOAD
#undef SWRITE
}
DI void attn_phase(const Params& p, char* lds) {
    const bf16_t* qp = (const bf16_t*)(p.ws + WS_QP); const bf16_t* kb = (const bf16_t*)(p.ws + WS_KB);
    const float* cosT = (const float*)(p.ws + WS_COS); const float* sinT = (const float*)(p.ws + WS_SIN);
    bf16_t* amix = (bf16_t*)(p.ws + WS_AMIX);
    for (int u = blockIdx.x; u < 256; u += gridDim.x) {
        const int b = u & 7, cp = u >> 3;
#pragma unroll 1
        for (int half = 0; half < 2; ++half) attn_unit(b, half ? cp : 63 - cp, qp, kb, cosT, sinT, amix, lds);
    }
}
}

DI void final_norm_phase(float* X, const float* g) {
    const int tid = otid(), lane = tid & 63, gw = blockIdx.x * 8 + (tid >> 6), nw = gridDim.x * 8;
    for (int row = gw; row < M_TOK; row += nw) {
        float* xr = X + (size_t)row * DM;
        f32x4 v[4]; float ss = 0.f;
#pragma unroll
        for (int i = 0; i < 4; ++i) { v[i] = *(const f32x4*)(xr + i * 256 + lane * 4); ss += v[i][0] * v[i][0] + v[i][1] * v[i][1] + v[i][2] * v[i][2] + v[i][3] * v[i][3]; }
        ss = wave_sum(ss);
        const float rstd = 1.0f / sqrtf(ss * (1.0f / DM) + EPS);
#pragma unroll
        for (int i = 0; i < 4; ++i) { const f32x4 gg = *(const f32x4*)(g + i * 256 + lane * 4); *(f32x4*)(xr + i * 256 + lane * 4) = v[i] * rstd * gg; }
    }
}

#ifndef PROBE_DUP
#define PROBE_DUP 0
#endif
__global__ void __launch_bounds__(NTHREADS, 2) mla_block_fwd(Params p) {
    extern __shared__ __attribute__((aligned(16))) unsigned char lds[];
    cg::grid_group grid = cg::this_grid();
    const int G = gridDim.x, bx = blockIdx.x;
    const float* mod = (const float*)(p.ws + WS_MOD);
    bf16_t* H = (bf16_t*)(p.ws + WS_H);
    PG8_LAS unsigned char* ring = (PG8_LAS unsigned char*)lds;

#define REP(k) for (int rep_ = 0; rep_ < 1 + ((PROBE_DUP >> (k)) & 1); ++rep_)
    REP(0) { p0_prep(p, (float*)lds); grid.sync(); }
    REP(1) { norm_mod_phase(p.x, p.g_mix, mod, 0 * DM, 1 * DM, H); grid.sync(); }
    REP(2) { pg8::Gemm g{H, (const bf16_t*)(p.ws + WS_WIN), M_TOK, 1024, 1024}; pg8::StaticOrder S; S.init(M_TOK, 1024, G, bx);
      pg8::EpiStoreBf16 E{(bf16_t*)(p.ws + WS_PROJ), 1024};
      pg8::gemm_phase<pg8::EpiStoreBf16, pg8::StaticOrder, true, true>(ring, g, S, E); grid.sync(); }
    REP(3) { post_proj_phase(p); grid.sync(); }
    REP(4) { pg8::Gemm g{(const bf16_t*)(p.ws + WS_CQ), (const bf16_t*)(p.ws + WS_WQ), M_TOK, 768, 256}; pg8::StaticOrder S; S.init(M_TOK, 768, G, bx);
      pg8::EpiStoreBf16 E{(bf16_t*)(p.ws + WS_QP), 768};
      pg8::gemm_phase<pg8::EpiStoreBf16, pg8::StaticOrder, true, true>(ring, g, S, E); grid.sync(); }
    REP(5) { att::attn_phase(p, (char*)lds); grid.sync(); }
    REP(6) { pg8::Gemm g{(const bf16_t*)(p.ws + WS_AMIX), (const bf16_t*)(p.ws + WS_WMIX), M_TOK, 1024, 1024}; pg8::StaticOrder S; S.init(M_TOK, 1024, G, bx);
      pg8::EpiResid E{p.x, p.out, mod + 2 * DM};
      pg8::gemm_phase<pg8::EpiResid, pg8::StaticOrder, true, true>(ring, g, S, E); grid.sync(); }
    REP(7) { norm_mod_phase(p.out, p.g_ffn, mod, 3 * DM, 4 * DM, H); grid.sync(); }
    REP(8) { pg8::Gemm g{H, (const bf16_t*)(p.ws + WS_WGU), M_TOK, 2 * DFF, 1024}; pg8::StaticOrder S; S.init(M_TOK, 2 * DFF, G, bx);
      pg8::EpiSwiGLU E{(bf16_t*)(p.ws + WS_ACT), DFF};
      pg8::gemm_phase<pg8::EpiSwiGLU, pg8::StaticOrder, true, true>(ring, g, S, E); grid.sync(); }
    { pg8::Gemm g{(const bf16_t*)(p.ws + WS_ACT), (const bf16_t*)(p.ws + WS_WDN), M_TOK, 1024, DFF}; pg8::StaticOrder S; S.init(M_TOK, 1024, G, bx);
      pg8::EpiResid E{p.out, p.out, mod + 5 * DM};
      pg8::gemm_phase<pg8::EpiResid, pg8::StaticOrder, true, true>(ring, g, S, E); grid.sync(); }
    final_norm_phase(p.out, p.g_final);
}

extern "C" void kernel_launch(void* const* d_in, const int* in_sizes, int n_in, void* d_out, int out_size, void* d_ws, size_t ws_size, hipStream_t stream) {
    static int grid_blocks = 0;
    if (!grid_blocks) {
        if (n_in != 20 || out_size != M_TOK * DM || ws_size < WS_END) { fprintf(stderr, "kernel_launch: unexpected shapes n_in %d out %d ws %zu\n", n_in, out_size, ws_size); return; }
        if (hipFuncSetAttribute((const void*)mla_block_fwd, hipFuncAttributeMaxDynamicSharedMemorySize, LDS_BYTES) != hipSuccess) { fprintf(stderr, "kernel_launch: hipFuncSetAttribute failed\n"); return; }
        int dev = 0, cus = 0, per_cu = 0;
        hipGetDevice(&dev);
        hipDeviceGetAttribute(&cus, hipDeviceAttributeMultiprocessorCount, dev);
        if (hipOccupancyMaxActiveBlocksPerMultiprocessor(&per_cu, (const void*)mla_block_fwd, NTHREADS, LDS_BYTES) != hipSuccess || per_cu < 1) { fprintf(stderr, "kernel_launch: occupancy query failed\n"); return; }
        grid_blocks = cus * 1;
    }
    Params p{};
    p.x = (const float*)d_in[0]; p.c = (const float*)d_in[1]; p.pos = (const int*)d_in[2]; p.w_ada = (const float*)d_in[3]; p.b_ada = (const float*)d_in[4];
    p.g_mix = (const float*)d_in[5]; p.w_in = (const float*)d_in[6]; p.g_q = (const float*)d_in[7]; p.g_kv = (const float*)d_in[8]; p.w_uq = (const float*)d_in[9];
    p.w_uk = (const float*)d_in[10]; p.w_uv = (const float*)d_in[11]; p.w_pool = (const float*)d_in[12]; p.pool_scale = (const float*)d_in[13]; p.w_o = (const float*)d_in[14];
    p.g_ffn = (const float*)d_in[15]; p.w_gate = (const float*)d_in[16]; p.w_up = (const float*)d_in[17]; p.w_down = (const float*)d_in[18]; p.g_final = (const float*)d_in[19];
    p.out = (float*)d_out; p.ws = (unsigned char*)d_ws;
    void* args[] = {&p};
    hipError_t e = hipLaunchCooperativeKernel((const void*)mla_block_fwd, dim3(grid_blocks), dim3(NTHREADS), args, LDS_BYTES, stream);
    if (e != hipSuccess) fprintf(stderr, "kernel_launch: cooperative launch failed: %s (grid %d)\n", hipGetErrorString(e), grid_blocks);
}
```

```cpp
#include <hip/hip_runtime.h>
#include <hip/hip_cooperative_groups.h>
#include <cstdio>
#include <cstdint>
namespace cg = cooperative_groups;
namespace pg8 {
#define PG8_LAS __attribute__((address_space(3)))
typedef unsigned short bf16_t;
typedef short bf16x8 __attribute__((ext_vector_type(8)));
typedef float f32x4 __attribute__((ext_vector_type(4)));
typedef unsigned u32x4 __attribute__((ext_vector_type(4)));
constexpr int BM = 256, BK = 64, HALF = 128, HTB = HALF * BK * 2  , STAGE_BYTES = 8 * HTB, NXCD = 8, WGM = 8;

__host__ __device__ __forceinline__ int lds_byte(int r, int c) { const int st = (r >> 4) * 2 + (c >> 5), rr = r & 15, cc = c & 31, ob = rr * 64 + cc * 2; return st * 1024 + (ob ^ (((ob >> 9) & 1) << 5)); }
__host__ __device__ __forceinline__ void stage_rc(int b, int& R, int& C) { const int st = b / 1024, sb = b % 1024, swz = sb ^ (((sb >> 9) & 1) << 5); R = (st >> 1) * 16 + swz / 64; C = (st & 1) * 32 + (swz % 64) / 2; }
__host__ __device__ __forceinline__ int perm32(int rho) { const int n = rho >> 4, i = rho & 15; return 8 * (i >> 2) + 4 * n + (i & 3); }

struct Unit { int pm, pn; };
struct Gemm { const bf16_t* A; const bf16_t* Bt; int M, N, K; };

struct StaticOrder {
    int nM, nN, nwg, G, c;
    __host__ __device__ void init(int M, int N, int G_, int c_) { nM = M / BM; nN = N / BM; nwg = nM * nN; G = G_; c = c_; }
    __host__ __device__ bool next(int i, Unit& u) const {
        const long L = (long)i * G + c; if (L >= nwg) return false;
        int wgid = (int)L; { const int q = nwg / NXCD, r = nwg % NXCD, xcd = wgid % NXCD, off = wgid / NXCD; wgid = (xcd < r ? xcd * (q + 1) : r * (q + 1) + (xcd - r) * q) + off; }
        const int nig = WGM * nN, gid = wgid / nig, fm = gid * WGM, gsz = (nM - fm) < WGM ? (nM - fm) : WGM;
        u.pm = fm + ((wgid % nig) % gsz); u.pn = (wgid % nig) / gsz; return true;
    }
    __device__ __forceinline__ void a_ready(const Unit&) const {}
    __device__ __forceinline__ void done(const Unit&) const {}
};

__device__ __forceinline__ unsigned cvt_pk_bf16(float lo, float hi) { unsigned r; asm volatile("v_cvt_pk_bf16_f32 %0, %1, %2" : "=v"(r) : "v"(lo), "v"(hi)); return r; }

struct EpiStoreBf16 {
    static constexpr bool PERM = true, AFTER_DRAIN = false;
    bf16_t* O; int ldc;
    __device__ __forceinline__ void operator()(const f32x4 (&acc)[2][2][4][2], const Unit& u, int wr, int wc, int fr, int fq) const {
        const int row0 = u.pm * BM + wr * 64 + fr, col0 = u.pn * BM + wc * 32 + 8 * fq;
#pragma unroll
        for (int ai = 0; ai < 2; ++ai)
#pragma unroll
            for (int m = 0; m < 4; ++m) { bf16_t* rowp = O + (size_t)(row0 + ai * HALF + m * 16) * ldc + col0;
#pragma unroll
                for (int bj = 0; bj < 2; ++bj) { const f32x4 v0 = acc[ai][bj][m][0], v1 = acc[ai][bj][m][1];
                    u32x4 w; w.x = cvt_pk_bf16(v0[0], v0[1]); w.y = cvt_pk_bf16(v0[2], v0[3]); w.z = cvt_pk_bf16(v1[0], v1[1]); w.w = cvt_pk_bf16(v1[2], v1[3]);
                    *(u32x4*)(rowp + bj * HALF) = w; } }
    }
};
struct EpiResid {
    static constexpr bool PERM = true, AFTER_DRAIN = false;
    const float* X; float* Out; const float* gate;
    __device__ __forceinline__ void operator()(const f32x4 (&acc)[2][2][4][2], const Unit& u, int wr, int wc, int fr, int fq) const {
        const int row0 = u.pm * BM + wr * 64 + fr, col0 = u.pn * BM + wc * 32 + 8 * fq;
        const float* gp = gate + (size_t)((u.pm * BM) >> 12) * 6144 + col0;
        f32x4 gv[2][2];
#pragma unroll
        for (int bj = 0; bj < 2; ++bj)
#pragma unroll
            for (int n = 0; n < 2; ++n) gv[bj][n] = *(const f32x4*)(gp + bj * HALF + 4 * n);
#pragma unroll
        for (int ai = 0; ai < 2; ++ai)
#pragma unroll
            for (int m = 0; m < 4; ++m) { const size_t ro = (size_t)(row0 + ai * HALF + m * 16) * 1024 + col0;
#pragma unroll
                for (int bj = 0; bj < 2; ++bj) {
                    const f32x4 x0 = *(const f32x4*)(X + ro + bj * HALF), x1 = *(const f32x4*)(X + ro + bj * HALF + 4);
                    const f32x4 o0 = x0 + gv[bj][0] * acc[ai][bj][m][0], o1 = x1 + gv[bj][1] * acc[ai][bj][m][1];
                    *(f32x4*)(Out + ro + bj * HALF) = o0; *(f32x4*)(Out + ro + bj * HALF + 4) = o1; } }
    }
};
struct EpiSwiGLU {
    static constexpr bool PERM = true, AFTER_DRAIN = false;
    bf16_t* O; int ldc;
    __device__ __forceinline__ void operator()(const f32x4 (&acc)[2][2][4][2], const Unit& u, int wr, int wc, int fr, int fq) const {
        const int row0 = u.pm * BM + wr * 64 + fr, col0 = u.pn * HALF + wc * 32 + 8 * fq;
#pragma unroll
        for (int ai = 0; ai < 2; ++ai)
#pragma unroll
            for (int m = 0; m < 4; ++m) { bf16_t* rowp = O + (size_t)(row0 + ai * HALF + m * 16) * ldc + col0;
                float a[8];
#pragma unroll
                for (int n = 0; n < 2; ++n)
#pragma unroll
                    for (int e = 0; e < 4; ++e) { const float g = acc[ai][0][m][n][e], up = acc[ai][1][m][n][e];
                        a[4 * n + e] = g * __builtin_amdgcn_rcpf(1.0f + __expf(-g)) * up; }
                u32x4 w; w.x = cvt_pk_bf16(a[0], a[1]); w.y = cvt_pk_bf16(a[2], a[3]); w.z = cvt_pk_bf16(a[4], a[5]); w.w = cvt_pk_bf16(a[6], a[7]);
                *(u32x4*)rowp = w; }
    }
};

template <class Epi, class Sched, bool ALIGN_EPI = false, bool SP2 = false>
__device__ __forceinline__ void gemm_phase(PG8_LAS unsigned char* lds, const Gemm g, const Sched& S, const Epi& E) {
    int tid_ = threadIdx.x; asm volatile("" : "+v"(tid_));
    const int tid = tid_, wid = __builtin_amdgcn_readfirstlane(tid >> 6), lane = tid & 63, wr = wid >> 2, wc = wid & 3, fr = lane & 15, fq = lane >> 4;
    const int K = g.K, nt = K / BK;
    unsigned voffA[2], voffB[2];
#pragma unroll
    for (int i = 0; i < 2; ++i) { int R, C; stage_rc(tid * 16 + i * 8192, R, C); const int Rb = Epi::PERM ? ((R & ~31) + perm32(R & 31)) : R;
        voffA[i] = (unsigned)(R * K + C) * 2u; voffB[i] = (unsigned)(Rb * K + C) * 2u; }
    const size_t kstep = (size_t)(BK * 2);
    const size_t hstep = (size_t)HALF * K * 2;
    const size_t tstep = 2 * hstep;
    const unsigned ldsw = (unsigned)wid * 1024u;
    const int aoff = lds_byte(wr * 64 + fr, fq * 8), boff = lds_byte(wc * 32 + fr, fq * 8);
#define PG8_SA(b, h) (((b) * 2 + (h)) * HTB)
#define PG8_SB(b, h) ((4 + (b) * 2 + (h)) * HTB)
#define PG8_STAGE(bufoff, gbase, voff) do { _Pragma("unroll") for (int _i = 0; _i < 2; ++_i) \
        __builtin_amdgcn_global_load_lds((const unsigned*)((const char*)(gbase) + (voff)[_i]), (PG8_LAS unsigned*)(lds + (bufoff) + ldsw + _i * 8192), 16, 0, 0); } while (0)
#define PG8_LDA(dst, b, h) do { _Pragma("unroll") for (int m = 0; m < 4; ++m) _Pragma("unroll") for (int k = 0; k < 2; ++k) dst[m][k] = *(const PG8_LAS bf16x8*)(lds + PG8_SA(b, h) + aoff + m * 2048 + k * 1024); } while (0)
#define PG8_LDB(dst, b, h) do { _Pragma("unroll") for (int n = 0; n < 2; ++n) _Pragma("unroll") for (int k = 0; k < 2; ++k) dst[n][k] = *(const PG8_LAS bf16x8*)(lds + PG8_SB(b, h) + boff + n * 2048 + k * 1024); } while (0)
#define PG8_MMA(ai, bj, At, Bt) do { __builtin_amdgcn_s_setprio(1); _Pragma("unroll") for (int m = 0; m < 4; ++m) _Pragma("unroll") for (int n = 0; n < 2; ++n) _Pragma("unroll") for (int k = 0; k < 2; ++k) \
        acc[ai][bj][m][n] = __builtin_amdgcn_mfma_f32_16x16x32_bf16(Bt[n][k], At[m][k], acc[ai][bj][m][n], 0, 0, 0); __builtin_amdgcn_s_setprio(0); } while (0)
#define PG8_WAIT_V(n) asm volatile("s_waitcnt vmcnt(" #n ")" ::: "memory")
#define PG8_WAIT_L(n) asm volatile("s_waitcnt lgkmcnt(" #n ")" ::: "memory")
#define PG8_BAR __builtin_amdgcn_s_barrier()
#define PG8_SCHED __builtin_amdgcn_sched_barrier(0)
    Unit cur, nxt; int ui = 0;
    if (!S.next(0, cur)) return;
    f32x4 acc[2][2][4][2];
#pragma unroll
    for (int a = 0; a < 2; ++a)
#pragma unroll
        for (int b = 0; b < 2; ++b)
#pragma unroll
            for (int m = 0; m < 4; ++m)
#pragma unroll
                for (int n = 0; n < 2; ++n) acc[a][b][m][n] = (f32x4){0.f, 0.f, 0.f, 0.f};
    bf16x8 At[4][2], B0[2][2], B1[2][2];
    const char* cA = (const char*)g.A + (size_t)cur.pm * tstep; const char* cB = (const char*)g.Bt + (size_t)cur.pn * tstep;
    S.a_ready(cur);
    if constexpr (SP2) {
        PG8_STAGE(PG8_SB(0, 0), cB, voffB); PG8_STAGE(PG8_SB(0, 1), cB + hstep, voffB); PG8_STAGE(PG8_SA(0, 0), cA, voffA); PG8_STAGE(PG8_SA(0, 1), cA + hstep, voffA);
        if (wr == 1) PG8_BAR;
        PG8_WAIT_V(2); PG8_BAR;
        PG8_STAGE(PG8_SB(1, 0), cB + kstep, voffB); PG8_STAGE(PG8_SA(1, 0), cA + kstep, voffA); PG8_STAGE(PG8_SB(1, 1), cB + hstep + kstep, voffB);
        PG8_WAIT_V(6); PG8_BAR;
    } else {
        PG8_STAGE(PG8_SB(0, 0), cB, voffB); PG8_STAGE(PG8_SA(0, 0), cA, voffA); PG8_STAGE(PG8_SB(0, 1), cB + hstep, voffB); PG8_STAGE(PG8_SA(0, 1), cA + hstep, voffA);
        if (wr == 1) PG8_BAR;
        PG8_WAIT_V(4); PG8_BAR;
        PG8_STAGE(PG8_SB(1, 0), cB + kstep, voffB); PG8_STAGE(PG8_SA(1, 0), cA + kstep, voffA); PG8_STAGE(PG8_SB(1, 1), cB + hstep + kstep, voffB);
        PG8_WAIT_V(6); PG8_BAR;
    }
    for (;;) {
        const bool has_next = S.next(ui + 1, nxt);
        const char* nA = has_next ? (const char*)g.A + (size_t)nxt.pm * tstep : cA; const char* nB = has_next ? (const char*)g.Bt + (size_t)nxt.pn * tstep : cB;
        for (int t = 0; t < nt; t += 2) {
            const bool last = (t == nt - 2);
            const char* a1 = cA + (size_t)(t + 1) * kstep;
            const char* a2 = last ? nA : cA + (size_t)(t + 2) * kstep; const char* b2 = last ? nB : cB + (size_t)(t + 2) * kstep;
            const char* a3 = a2 + kstep; const char* b3 = b2 + kstep;
            if (last && has_next) S.a_ready(nxt);
            if constexpr (SP2) {
            PG8_LDB(B0, 0, 0); PG8_LDB(B1, 0, 1); PG8_SCHED; PG8_LDA(At, 0, 0); PG8_STAGE(PG8_SA(1, 1), a1 + hstep, voffA);
            PG8_WAIT_V(8); PG8_WAIT_L(0); PG8_BAR; PG8_MMA(0, 0, At, B0); PG8_MMA(0, 1, At, B1); PG8_BAR; PG8_SCHED;
            PG8_LDA(At, 0, 1); PG8_STAGE(PG8_SB(0, 0), b2, voffB); PG8_STAGE(PG8_SB(0, 1), b2 + hstep, voffB); PG8_STAGE(PG8_SA(0, 0), a2, voffA);
            PG8_WAIT_V(8); PG8_WAIT_L(0); PG8_BAR; PG8_MMA(1, 0, At, B0); PG8_MMA(1, 1, At, B1); PG8_BAR; PG8_SCHED;
            PG8_LDB(B0, 1, 0); PG8_LDB(B1, 1, 1); PG8_SCHED; PG8_LDA(At, 1, 0); PG8_STAGE(PG8_SA(0, 1), a2 + hstep, voffA);
            PG8_WAIT_V(8); PG8_WAIT_L(0); PG8_BAR; PG8_MMA(0, 0, At, B0); PG8_MMA(0, 1, At, B1); PG8_BAR; PG8_SCHED;
            PG8_LDA(At, 1, 1); PG8_STAGE(PG8_SB(1, 0), b3, voffB); PG8_STAGE(PG8_SB(1, 1), b3 + hstep, voffB); PG8_STAGE(PG8_SA(1, 0), a3, voffA);
            PG8_WAIT_V(8); PG8_WAIT_L(0); PG8_BAR; PG8_MMA(1, 0, At, B0); PG8_MMA(1, 1, At, B1); PG8_BAR; PG8_SCHED;
            } else {
            PG8_LDB(B0, 0, 0); PG8_SCHED; PG8_LDA(At, 0, 0); PG8_STAGE(PG8_SA(1, 1), a1 + hstep, voffA);
            PG8_WAIT_L(8); PG8_BAR; PG8_WAIT_L(0); PG8_MMA(0, 0, At, B0); PG8_BAR; PG8_SCHED;
            PG8_LDB(B1, 0, 1); PG8_STAGE(PG8_SB(0, 0), b2, voffB);
            PG8_BAR; PG8_WAIT_L(0); PG8_MMA(0, 1, At, B1); PG8_BAR;
            PG8_LDA(At, 0, 1); PG8_STAGE(PG8_SA(0, 0), a2, voffA);
            PG8_BAR; PG8_WAIT_L(0); PG8_MMA(1, 0, At, B0); PG8_BAR; PG8_SCHED;
            PG8_STAGE(PG8_SB(0, 1), b2 + hstep, voffB);
            PG8_WAIT_V(6); PG8_BAR; PG8_MMA(1, 1, At, B1); PG8_BAR;
            PG8_LDB(B0, 1, 0); PG8_SCHED; PG8_LDA(At, 1, 0); PG8_STAGE(PG8_SA(0, 1), a2 + hstep, voffA);
            PG8_WAIT_L(8); PG8_BAR; PG8_WAIT_L(0); PG8_MMA(0, 0, At, B0); PG8_BAR; PG8_SCHED;
            PG8_LDB(B1, 1, 1); PG8_STAGE(PG8_SB(1, 0), b3, voffB);
            PG8_BAR; PG8_WAIT_L(0); PG8_MMA(0, 1, At, B1); PG8_BAR;
            PG8_LDA(At, 1, 1); PG8_STAGE(PG8_SA(1, 0), a3, voffA);
            PG8_BAR; PG8_WAIT_L(0); PG8_MMA(1, 0, At, B0); PG8_BAR; PG8_SCHED;
            PG8_STAGE(PG8_SB(1, 1), b3 + hstep, voffB);
            PG8_WAIT_V(6); PG8_BAR; PG8_MMA(1, 1, At, B1); PG8_BAR;
            }
        }
        if constexpr (ALIGN_EPI) { if (wr == 0) PG8_BAR; }
        if constexpr (!Epi::AFTER_DRAIN) { E(acc, cur, wr, wc, fr, fq); S.done(cur); }
        if (!has_next) break;
#pragma unroll
        for (int a = 0; a < 2; ++a)
#pragma unroll
            for (int b = 0; b < 2; ++b)
#pragma unroll
                for (int m = 0; m < 4; ++m)
#pragma unroll
                    for (int n = 0; n < 2; ++n) acc[a][b][m][n] = (f32x4){0.f, 0.f, 0.f, 0.f};
        cur = nxt; cA = nA; cB = nB; ++ui;
        if constexpr (ALIGN_EPI) { if (wr == 1) PG8_BAR; }
    }
    PG8_WAIT_V(0);
    if constexpr (!ALIGN_EPI) { if (wr == 0) PG8_BAR; }
    PG8_BAR;
    if constexpr (Epi::AFTER_DRAIN) { E.fused(acc, cur, wr, wc, fr, fq, lds, wid, lane); S.done(cur); }
#undef PG8_SA
#undef PG8_SB
#undef PG8_STAGE
#undef PG8_LDA
#undef PG8_LDB
#undef PG8_MMA
#undef PG8_WAIT_V
#undef PG8_WAIT_L
#undef PG8_BAR
#undef PG8_SCHED
}
}

typedef unsigned short bf16_t;
typedef short bf16x8 __attribute__((ext_vector_type(8)));
typedef short s16x4 __attribute__((ext_vector_type(4)));
typedef float f32x4 __attribute__((ext_vector_type(4)));
typedef float f32x16 __attribute__((ext_vector_type(16)));
typedef unsigned u32x4 __attribute__((ext_vector_type(4)));
typedef unsigned u32x2 __attribute__((ext_vector_type(2)));
#define DI __device__ __forceinline__

constexpr int M_TOK = 32768, DM = 1024, SEQ = 4096, NB = 8, DFF = 2816, NMOD = 6144;
constexpr float EPS = 1e-6f;
constexpr int NTHREADS = 512;

constexpr size_t MiB = 1u << 20;
constexpr size_t WS_MOD = 0;
constexpr size_t WS_COS = 1 * MiB, WS_SIN = 5 * MiB;
constexpr size_t WS_WIN = 16 * MiB;
constexpr size_t WS_WQ = 18 * MiB;
constexpr size_t WS_WMIX = 19 * MiB;
constexpr size_t WS_WGU = 21 * MiB;
constexpr size_t WS_WDN = 32 * MiB;
constexpr size_t WS_H = 64 * MiB;
constexpr size_t WS_ACT = 128 * MiB;
constexpr size_t WS_PROJ = 128 * MiB;
constexpr size_t WS_AMIX = 192 * MiB;
constexpr size_t WS_QP = 256 * MiB;
constexpr size_t WS_CQ = 304 * MiB;
constexpr size_t WS_KB = 320 * MiB;
constexpr size_t WS_END = 332 * MiB;

constexpr int LDS_BYTES = 135168;

struct Params {
    const float* x; const float* c; const int* pos; const float* w_ada; const float* b_ada; const float* g_mix; const float* w_in;
    const float* g_q; const float* g_kv; const float* w_uq; const float* w_uk; const float* w_uv; const float* w_pool; const float* pool_scale;
    const float* w_o; const float* g_ffn; const float* w_gate; const float* w_up; const float* w_down; const float* g_final;
    float* out; unsigned char* ws;
};

DI float bf2f(unsigned short h) { return __uint_as_float((unsigned)h << 16); }
DI unsigned cvtpk(float lo, float hi) { unsigned r; asm volatile("v_cvt_pk_bf16_f32 %0, %1, %2" : "=v"(r) : "v"(lo), "v"(hi)); return r; }
DI int otid() { int t = threadIdx.x; asm volatile("" : "+v"(t)); return t; }
DI float wave_sum(float v) {
#pragma unroll
    for (int o = 32; o >= 1; o >>= 1) v += __shfl_xor(v, o);
    return v;
}

constexpr int N_FMIX = 128, N_ADA = 192, N_FQ = 64, N_TR_IN = 64, N_TR_G = 176, N_TR_U = 176, N_TR_D = 176;
constexpr int N_ITEMS = N_FMIX + N_ADA + N_FQ + N_TR_IN + N_TR_G + N_TR_U + N_TR_D;

DI void p0_fold_mix(const Params& p, int item, float* lds) {
    const int tid = otid(), blk = item >> 4, nt = item & 15;
    float* L = lds;
    float* Wo = lds + 128 * 132;
    for (int i = tid; i < 128 * 32; i += NTHREADS) {
        const int cc = i >> 5, v4 = (i & 31) * 4;
        f32x4 v;
        if (blk < 4) v = *(const f32x4*)(p.w_uv + (size_t)(cc * 4 + blk) * 128 + v4);
        else { const int g = blk - 4; v = *(const f32x4*)(p.w_pool + (size_t)(g * 128 + cc) * 128 + v4) * *(const f32x4*)(p.pool_scale + g * 128 + v4); }
        *(f32x4*)(L + cc * 132 + v4) = v;
    }
    for (int i = tid; i < 128 * 16; i += NTHREADS) {
        const int v = i >> 4, n4 = (i & 15) * 4;
        *(f32x4*)(Wo + v * 64 + n4) = *(const f32x4*)(p.w_o + (size_t)(blk * 128 + v) * 1024 + nt * 64 + n4);
    }
    __syncthreads();
    const int n = tid & 63, ccg = tid >> 6;
    float acc[16];
#pragma unroll
    for (int i = 0; i < 16; ++i) acc[i] = 0.f;
    for (int v4 = 0; v4 < 128; v4 += 4) {
        const float w0 = Wo[(v4 + 0) * 64 + n], w1 = Wo[(v4 + 1) * 64 + n], w2 = Wo[(v4 + 2) * 64 + n], w3 = Wo[(v4 + 3) * 64 + n];
#pragma unroll
        for (int i = 0; i < 16; ++i) { const f32x4 l = *(const f32x4*)(L + (ccg * 16 + i) * 132 + v4);
            acc[i] = fmaf(l[0], w0, acc[i]); acc[i] = fmaf(l[1], w1, acc[i]); acc[i] = fmaf(l[2], w2, acc[i]); acc[i] = fmaf(l[3], w3, acc[i]); }
    }
    bf16_t* dst = (bf16_t*)(p.ws + WS_WMIX) + (size_t)(nt * 64 + n) * 1024 + blk * 128 + ccg * 16;
    u32x4 w0, w1;
    w0.x = cvtpk(acc[0], acc[1]); w0.y = cvtpk(acc[2], acc[3]); w0.z = cvtpk(acc[4], acc[5]); w0.w = cvtpk(acc[6], acc[7]);
    w1.x = cvtpk(acc[8], acc[9]); w1.y = cvtpk(acc[10], acc[11]); w1.z = cvtpk(acc[12], acc[13]); w1.w = cvtpk(acc[14], acc[15]);
    *(u32x4*)dst = w0; *(u32x4*)(dst + 8) = w1;
    __syncthreads();
}

DI void p0_ada(const Params& p, int item, float* lds) {
    const int tid = otid(), n0 = item * 32, col = tid & 31, kg = tid >> 5;
    float* cact = lds;
    float* red = lds + 8192;
    for (int i = tid; i < 8192; i += NTHREADS) { const float v = p.c[i]; cact[i] = v / (1.0f + __expf(-v)); }
    __syncthreads();
    float acc[8];
#pragma unroll
    for (int b = 0; b < 8; ++b) acc[b] = 0.f;
    const float* wp = p.w_ada + (size_t)(kg * 64) * NMOD + n0 + col;
#pragma unroll 16
    for (int kk = 0; kk < 64; ++kk) {
        const float w = wp[(size_t)kk * NMOD];
#pragma unroll
        for (int b = 0; b < 8; ++b) acc[b] = fmaf(cact[b * 1024 + kg * 64 + kk], w, acc[b]);
    }
#pragma unroll
    for (int b = 0; b < 8; ++b) red[(kg * 8 + b) * 32 + col] = acc[b];
    __syncthreads();
    if (tid < 256) {
        const int b = tid >> 5; float s = 0.f;
#pragma unroll
        for (int g = 0; g < 16; ++g) s += red[(g * 8 + b) * 32 + col];
        ((float*)(p.ws + WS_MOD))[b * NMOD + n0 + col] = s + p.b_ada[n0 + col];
    }
    __syncthreads();
}

DI void p0_fold_q(const Params& p, int item, float* lds) {
    const int tid = otid(), h = item >> 4, r0 = (item & 15) * 16;
    float* Bs = lds;
    float* As = lds + 128 * 132;
    for (int i = tid; i < 128 * 32; i += NTHREADS) { const int cc = i >> 5, d4 = (i & 31) * 4;
        *(f32x4*)(Bs + cc * 132 + d4) = *(const f32x4*)(p.w_uk + (size_t)(cc * 4 + h) * 128 + d4); }
    { const int rr = tid >> 5, d4 = (tid & 31) * 4;
      *(f32x4*)(As + rr * 132 + d4) = *(const f32x4*)(p.w_uq + (size_t)((r0 + rr) * 4 + h) * 192 + d4) * p.g_q[r0 + rr]; }
    __syncthreads();
    const int rr = tid & 15, ccg = tid >> 4;
    float acc[4] = {0.f, 0.f, 0.f, 0.f};
    for (int d4 = 0; d4 < 128; d4 += 4) { const f32x4 a = *(const f32x4*)(As + rr * 132 + d4);
#pragma unroll
        for (int i = 0; i < 4; ++i) { const f32x4 q = *(const f32x4*)(Bs + (ccg * 4 + i) * 132 + d4);
            acc[i] = fmaf(a[0], q[0], acc[i]); acc[i] = fmaf(a[1], q[1], acc[i]); acc[i] = fmaf(a[2], q[2], acc[i]); acc[i] = fmaf(a[3], q[3], acc[i]); } }
    bf16_t* wq = (bf16_t*)(p.ws + WS_WQ);
#pragma unroll
    for (int i = 0; i < 4; ++i) wq[(size_t)(h * 128 + ccg * 4 + i) * 256 + r0 + rr] = (bf16_t)(cvtpk(acc[i], 0.f) & 0xffffu);
    for (int e = tid; e < 1024; e += NTHREADS) { const int j = e & 63, r = r0 + (e >> 6);
        const float v = p.w_uq[(size_t)(r * 4 + h) * 192 + 128 + j] * p.g_q[r];
        wq[(size_t)(512 + h * 64 + j) * 256 + r] = (bf16_t)(cvtpk(v, 0.f) & 0xffffu); }
    __syncthreads();
}

DI void p0_transpose(const float* src, int ld_src, int n_valid, bf16_t* dst, int ld_dst, int kt, int nslab, int kind, float* lds) {
    const int tid = otid(), k0 = kt * 64, n0 = nslab * 256;
    float* tile = lds;
    f32x4 v[8];
#pragma unroll
    for (int i = 0; i < 8; ++i) { const int idx = tid + NTHREADS * i, kk = idx >> 6, nn4 = (idx & 63) * 4;
        v[i] = (f32x4){0.f, 0.f, 0.f, 0.f};
        if (n0 + nn4 < n_valid) v[i] = *(const f32x4*)(src + (size_t)(k0 + kk) * ld_src + n0 + nn4); }
#pragma unroll
    for (int i = 0; i < 8; ++i) { const int idx = tid + NTHREADS * i, kk = idx >> 6, nn4 = (idx & 63) * 4;
        tile[kk * 257 + nn4 + 0] = v[i][0]; tile[kk * 257 + nn4 + 1] = v[i][1]; tile[kk * 257 + nn4 + 2] = v[i][2]; tile[kk * 257 + nn4 + 3] = v[i][3]; }
    __syncthreads();
#pragma unroll
    for (int i = 0; i < 4; ++i) { const int c = tid + NTHREADS * i, nn = c >> 3, ks = (c & 7) * 8, n = n0 + nn;
        int drow = n;
        if (kind == 1) drow = (n >> 7) * 256 + (n & 127);
        else if (kind == 2) drow = (n >> 7) * 256 + 128 + (n & 127);
        u32x4 w;
        w.x = cvtpk(tile[(ks + 0) * 257 + nn], tile[(ks + 1) * 257 + nn]); w.y = cvtpk(tile[(ks + 2) * 257 + nn], tile[(ks + 3) * 257 + nn]);
        w.z = cvtpk(tile[(ks + 4) * 257 + nn], tile[(ks + 5) * 257 + nn]); w.w = cvtpk(tile[(ks + 6) * 257 + nn], tile[(ks + 7) * 257 + nn]);
        *(u32x4*)(dst + (size_t)drow * ld_dst + k0 + ks) = w; }
    __syncthreads();
}

DI void p0_prep(const Params& p, float* lds) {
    for (int it = blockIdx.x; it < N_ITEMS; it += gridDim.x) {
        int i = it;
        if (i < N_FMIX) { p0_fold_mix(p, i, lds); continue; } i -= N_FMIX;
        if (i < N_ADA) { p0_ada(p, i, lds); continue; } i -= N_ADA;
        if (i < N_FQ) { p0_fold_q(p, i, lds); continue; } i -= N_FQ;
        if (i < N_TR_IN) { p0_transpose(p.w_in, 960, 960, (bf16_t*)(p.ws + WS_WIN), 1024, i >> 2, i & 3, 0, lds); continue; } i -= N_TR_IN;
        if (i < N_TR_G) { p0_transpose(p.w_gate, DFF, DFF, (bf16_t*)(p.ws + WS_WGU), 1024, i / 11, i % 11, 1, lds); continue; } i -= N_TR_G;
        if (i < N_TR_U) { p0_transpose(p.w_up, DFF, DFF, (bf16_t*)(p.ws + WS_WGU), 1024, i / 11, i % 11, 2, lds); continue; } i -= N_TR_U;
        p0_transpose(p.w_down, DM, DM, (bf16_t*)(p.ws + WS_WDN), DFF, i >> 2, i & 3, 0, lds);
    }
}

DI void norm_mod_phase(const float* X, const float* g, const float* mod, int off_sh, int off_sc, bf16_t* H) {
    const int tid = otid(), lane = tid & 63, gw = blockIdx.x * 8 + (tid >> 6), nw = gridDim.x * 8;
    for (int base = gw * 16; base < M_TOK; base += nw * 16) {
        const int b = base >> 12;
        f32x4 gm[4], sh[4];
#pragma unroll
        for (int i = 0; i < 4; ++i) { const int col = i * 256 + lane * 4;
            gm[i] = *(const f32x4*)(g + col) * (*(const f32x4*)(mod + b * NMOD + off_sc + col) + 1.0f); sh[i] = *(const f32x4*)(mod + b * NMOD + off_sh + col); }
#pragma unroll 1
        for (int r0 = 0; r0 < 16; r0 += 4) {
            f32x4 v[4][4]; float ss[4];
#pragma unroll
            for (int rr = 0; rr < 4; ++rr)
#pragma unroll
                for (int i = 0; i < 4; ++i) v[rr][i] = *(const f32x4*)(X + (size_t)(base + r0 + rr) * DM + i * 256 + lane * 4);
#pragma unroll
            for (int rr = 0; rr < 4; ++rr) { float a = 0.f;
#pragma unroll
                for (int i = 0; i < 4; ++i) a += v[rr][i][0] * v[rr][i][0] + v[rr][i][1] * v[rr][i][1] + v[rr][i][2] * v[rr][i][2] + v[rr][i][3] * v[rr][i][3];
                ss[rr] = a; }
#pragma unroll
            for (int rr = 0; rr < 4; ++rr) ss[rr] = wave_sum(ss[rr]);
#pragma unroll
            for (int rr = 0; rr < 4; ++rr) { const float rstd = 1.0f / sqrtf(ss[rr] * (1.0f / DM) + EPS);
#pragma unroll
                for (int i = 0; i < 4; ++i) { const f32x4 y = v[rr][i] * rstd * gm[i] + sh[i];
                    u32x2 w; w.x = cvtpk(y[0], y[1]); w.y = cvtpk(y[2], y[3]);
                    *(u32x2*)(H + (size_t)(base + r0 + rr) * DM + i * 256 + lane * 4) = w; } }
        }
    }
}

DI void unpack8(const u32x4 q, float* f) {
    f[0] = __uint_as_float(q.x << 16); f[1] = __uint_as_float(q.x & 0xffff0000u); f[2] = __uint_as_float(q.y << 16); f[3] = __uint_as_float(q.y & 0xffff0000u);
    f[4] = __uint_as_float(q.z << 16); f[5] = __uint_as_float(q.z & 0xffff0000u); f[6] = __uint_as_float(q.w << 16); f[7] = __uint_as_float(q.w & 0xffff0000u);
}
DI void post_proj_phase(const Params& p) {
    const bf16_t* proj = (const bf16_t*)(p.ws + WS_PROJ);
    bf16_t* cq = (bf16_t*)(p.ws + WS_CQ); bf16_t* kb = (bf16_t*)(p.ws + WS_KB); bf16_t* amix = (bf16_t*)(p.ws + WS_AMIX);
    float* cosT = (float*)(p.ws + WS_COS); float* sinT = (float*)(p.ws + WS_SIN);
    const int tid = otid(), lane = tid & 63, gw = blockIdx.x * 8 + (tid >> 6), nw = gridDim.x * 8;
    const float freq = (float)exp2(-(double)(lane & 31) * (13.287712379549449 / 32.0));
    const float gkv0 = p.g_kv[lane * 2], gkv1 = p.g_kv[lane * 2 + 1];
    const int pc = lane * 8, w = 2 << (lane >> 4);
    for (int t0 = gw * 16; t0 < M_TOK; t0 += nw * 16) {
        const int s0 = t0 & (SEQ - 1);
        float sum[8];
#pragma unroll
        for (int e = 0; e < 8; ++e) sum[e] = 0.f;
#pragma unroll
        for (int i = 1; i < 16; ++i) {
            if (i < w && s0 - i >= 0) { float f[8]; unpack8(*(const u32x4*)(proj + (size_t)(t0 - i) * 1024 + 448 + pc), f);
#pragma unroll
                for (int e = 0; e < 8; ++e) sum[e] += f[e]; }
        }
#pragma unroll 2
        for (int k = 0; k < 16; ++k) {
            const int t = t0 + k, s = s0 + k;
            const bf16_t* row = proj + (size_t)t * 1024;
            const u32x2 wq = *(const u32x2*)(row + lane * 4);
            const unsigned wk = *(const unsigned*)(row + 256 + lane * 2);
            const u32x4 wu = *(const u32x4*)(row + 448 + pc);
            const bool drop = (s - w + 1 >= 0);
            u32x4 wd = (u32x4){0u, 0u, 0u, 0u};
            if (drop) wd = *(const u32x4*)(row - (size_t)(w - 1) * 1024 + 448 + pc);
            { const float a0 = __uint_as_float(wq.x << 16), a1 = __uint_as_float(wq.x & 0xffff0000u), a2 = __uint_as_float(wq.y << 16), a3 = __uint_as_float(wq.y & 0xffff0000u);
              const float ss = wave_sum(a0 * a0 + a1 * a1 + a2 * a2 + a3 * a3);
              const float rstd = 1.0f / sqrtf(ss * (1.0f / 256.0f) + EPS);
              u32x2 o; o.x = cvtpk(a0 * rstd, a1 * rstd); o.y = cvtpk(a2 * rstd, a3 * rstd);
              *(u32x2*)(cq + (size_t)t * 256 + lane * 4) = o; }
            { const float a0 = __uint_as_float(wk << 16), a1 = __uint_as_float(wk & 0xffff0000u);
              const float ss = wave_sum(a0 * a0 + a1 * a1);
              const float rstd = 1.0f / sqrtf(ss * (1.0f / 128.0f) + EPS);
              *(unsigned*)(kb + (size_t)t * 192 + lane * 2) = cvtpk(a0 * rstd * gkv0, a1 * rstd * gkv1); }
            if (lane < 32) {
                const float x1 = bf2f(row[384 + lane]), x2 = bf2f(row[384 + 32 + lane]);
                const float ang = (float)p.pos[t] * freq;
                float sn, cs; sincosf(ang, &sn, &cs);
                cosT[(size_t)t * 32 + lane] = cs; sinT[(size_t)t * 32 + lane] = sn;
                kb[(size_t)t * 192 + 128 + lane] = (bf16_t)(cvtpk(x1 * cs - x2 * sn, 0.f) & 0xffffu);
                kb[(size_t)t * 192 + 160 + lane] = (bf16_t)(cvtpk(x1 * sn + x2 * cs, 0.f) & 0xffffu);
            }
            { float f[8]; unpack8(wu, f);
#pragma unroll
              for (int e = 0; e < 8; ++e) sum[e] += f[e];
              const int cnt = (s + 1 < w) ? (s + 1) : w;
              const float inv = 1.0f / (float)cnt;
              u32x4 o;
              o.x = cvtpk(sum[0] * inv - f[0], sum[1] * inv - f[1]); o.y = cvtpk(sum[2] * inv - f[2], sum[3] * inv - f[3]);
              o.z = cvtpk(sum[4] * inv - f[4], sum[5] * inv - f[5]); o.w = cvtpk(sum[6] * inv - f[6], sum[7] * inv - f[7]);
              *(u32x4*)(amix + (size_t)t * 1024 + 512 + pc) = o;
              float d[8]; unpack8(wd, d);
#pragma unroll
              for (int e = 0; e < 8; ++e) sum[e] -= d[e]; }
        }
    }
}

namespace att {
constexpr float SCALE = 0.07216878364870322f;
constexpr float THR = 8.f;
constexpr int SHM_V = 64 * 128 * 2, SHM_K = 64 * 192 * 2;
constexpr int OFF_V = 0, OFF_K = 2 * SHM_V, OFF_WS = OFF_K + 2 * SHM_K, ATT_LDS = OFF_WS + 8 * 64 * 4;
#define KSWZ(row, colB) ((row) * 384 + ((colB) ^ (((row) & 7) << 4)))
#define SBAR() __builtin_amdgcn_sched_barrier(0)
DI int crow(int r, int hi) { return (r & 3) + 8 * (r >> 2) + 4 * hi; }

DI void partialSM(f32x16& p0, f32x16& p1, float& m_reg, float& mn, float& alpha) {
    constexpr float C = SCALE * 1.4426950408889634f;
    float pmax = p0[0];
#pragma unroll
    for (int r = 1; r < 16; ++r) pmax = fmaxf(pmax, p0[r]);
#pragma unroll
    for (int r = 0; r < 16; ++r) pmax = fmaxf(pmax, p1[r]);
    { auto rr = __builtin_amdgcn_permlane32_swap(__float_as_uint(pmax), __float_as_uint(pmax), false, false);
      pmax = fmaxf(__uint_as_float(rr[0]), __uint_as_float(rr[1])); }
    if (__builtin_expect(__all(pmax - m_reg <= THR / SCALE), 1)) { mn = m_reg; alpha = 1.f; }
    else { mn = fmaxf(m_reg, pmax); alpha = __builtin_amdgcn_exp2f((m_reg - mn) * C); m_reg = mn; }
    const float mnC = -mn * C;
#pragma unroll
    for (int r = 0; r < 16; ++r) p0[r] = fmaf(p0[r], C, mnC);
#pragma unroll
    for (int r = 0; r < 16; ++r) p1[r] = fmaf(p1[r], C, mnC);
#pragma unroll
    for (int r = 0; r < 16; ++r) p0[r] = __builtin_amdgcn_exp2f(p0[r]);
}
DI void finishSM(f32x16& p0, f32x16& p1, float alpha, float& l_reg, bf16x8& pa0, bf16x8& pa1, bf16x8& pa2, bf16x8& pa3) {
#pragma unroll
    for (int r = 0; r < 16; ++r) p1[r] = __builtin_amdgcn_exp2f(p1[r]);
    float ps = 0;
#pragma unroll
    for (int r = 0; r < 16; ++r) ps += p0[r];
#pragma unroll
    for (int r = 0; r < 16; ++r) ps += p1[r];
    { auto rr = __builtin_amdgcn_permlane32_swap(__float_as_uint(ps), __float_as_uint(ps), false, false);
      ps = __uint_as_float(rr[0]) + __uint_as_float(rr[1]); }
    l_reg = l_reg * alpha + ps;
#define PK4(P, BASE, OUT) do { unsigned a0 = cvtpk(P[BASE + 0], P[BASE + 1]), a1 = cvtpk(P[BASE + 2], P[BASE + 3]);   \
    unsigned b0 = cvtpk(P[BASE + 4], P[BASE + 5]), b1 = cvtpk(P[BASE + 6], P[BASE + 7]);                              \
    auto r0 = __builtin_amdgcn_permlane32_swap(a0, b0, false, false); auto r1 = __builtin_amdgcn_permlane32_swap(a1, b1, false, false); \
    u32x4 w = {r0[0], r1[0], r0[1], r1[1]}; OUT = __builtin_bit_cast(bf16x8, w); } while (0)
    PK4(p0, 0, pa0); PK4(p0, 8, pa1); PK4(p1, 0, pa2); PK4(p1, 8, pa3);
#undef PK4
}
DI void qkt(f32x16& p0, f32x16& p1, const char* Ks, const bf16x8* qr, int r32, int hi) {
#pragma unroll
    for (int r = 0; r < 16; ++r) { p0[r] = 0.f; p1[r] = 0.f; }
    const int sw = (r32 & 7) << 4, rb = r32 * 384;
    int o4[4];
#pragma unroll
    for (int q = 0; q < 4; ++q) o4[q] = rb + ((q * 32 + hi * 16) ^ sw);
#pragma unroll
    for (int d0 = 0; d0 < 12; ++d0) {
        const bf16x8 b0 = *reinterpret_cast<const bf16x8*>(Ks + o4[d0 & 3] + (d0 >> 2) * 128);
        const bf16x8 b1 = *reinterpret_cast<const bf16x8*>(Ks + o4[d0 & 3] + (d0 >> 2) * 128 + 32 * 384);
        p0 = __builtin_amdgcn_mfma_f32_32x32x16_bf16(b0, qr[d0], p0, 0, 0, 0);
        p1 = __builtin_amdgcn_mfma_f32_32x32x16_bf16(b1, qr[d0], p1, 0, 0, 0);
        if ((d0 & 3) == 3) SBAR(); }
}
DI int v_st(int k, int c) { const int kk = (k & ~0xC) | ((k & 4) << 1) | ((k & 8) >> 1); return ((kk >> 3) * 4 + (c >> 5)) * 512 + ((kk & 7) * 32 + (c & 31)) * 2; }
DI int v_rd_base(int lane) { return ((lane & 3) << 3) | (((lane >> 2) & 3) << 6) | (((lane >> 4) & 1) << 5) | (((lane >> 5) & 1) << 8); }
constexpr int v_rd_off(int d0, int ks, int half) { return d0 * 512 + ks * 4096 + half * 2048; }
template <int OFF> DI s16x4 tr_read(int vb) {
    s16x4 r; asm volatile("ds_read_b64_tr_b16 %0, %1 offset:%2" : "=&v"(r) : "v"(vb), "i"(OFF) : "memory"); return r;
}
template <int D0> DI void pv_one(f32x16& od, int vb, bf16x8 pa0, bf16x8 pa1, bf16x8 pa2, bf16x8 pa3) {
    const s16x4 l0 = tr_read<v_rd_off(D0, 0, 0)>(vb), h0 = tr_read<v_rd_off(D0, 0, 1)>(vb), l1 = tr_read<v_rd_off(D0, 1, 0)>(vb), h1 = tr_read<v_rd_off(D0, 1, 1)>(vb);
    const s16x4 l2 = tr_read<v_rd_off(D0, 2, 0)>(vb), h2 = tr_read<v_rd_off(D0, 2, 1)>(vb), l3 = tr_read<v_rd_off(D0, 3, 0)>(vb), h3 = tr_read<v_rd_off(D0, 3, 1)>(vb);
    asm volatile("s_waitcnt lgkmcnt(0)" ::: "memory"); SBAR();
#define PK(L, H) (bf16x8){L[0], L[1], L[2], L[3], H[0], H[1], H[2], H[3]}
    od = __builtin_amdgcn_mfma_f32_32x32x16_bf16(pa0, PK(l0, h0), od, 0, 0, 0);
    od = __builtin_amdgcn_mfma_f32_32x32x16_bf16(pa1, PK(l1, h1), od, 0, 0, 0);
    od = __builtin_amdgcn_mfma_f32_32x32x16_bf16(pa2, PK(l2, h2), od, 0, 0, 0);
    od = __builtin_amdgcn_mfma_f32_32x32x16_bf16(pa3, PK(l3, h3), od, 0, 0, 0);
#undef PK
}

DI void attn_unit(int b, int c, const bf16_t* __restrict__ qp, const bf16_t* __restrict__ Kb, const float* __restrict__ cosT, const float* __restrict__ sinT,
                  bf16_t* __restrict__ amix, char* lds) {
    int tid = threadIdx.x; asm volatile("" : "+v"(tid));
    const int wid = __builtin_amdgcn_readfirstlane(tid >> 6), lane = tid & 63, r32 = lane & 31, hi = lane >> 5, hq = wid >> 1;
    char* V_lds = lds + OFF_V; char* K_lds = lds + OFF_K;
    float* ws = (float*)(lds + OFF_WS) + wid * 64; float* li_l = ws; float* al_l = ws + 32;
    const int tok0 = b * SEQ + c * 64 + (wid & 1) * 32, tok = tok0 + r32;
    bf16x8 qr[12];
    const bf16_t* qrow = qp + (size_t)tok * 768;
#pragma unroll
    for (int d0 = 0; d0 < 8; ++d0) qr[d0] = *(const bf16x8*)(qrow + hq * 128 + d0 * 16 + hi * 8);
#pragma unroll
    for (int dd = 0; dd < 2; ++dd) {
        const int j0 = dd * 16 + hi * 8;
        const bf16x8 x1 = *(const bf16x8*)(qrow + 512 + hq * 64 + j0), x2 = *(const bf16x8*)(qrow + 512 + hq * 64 + 32 + j0);
        const f32x4 c0 = *(const f32x4*)(cosT + (size_t)tok * 32 + j0), c1 = *(const f32x4*)(cosT + (size_t)tok * 32 + j0 + 4);
        const f32x4 s0 = *(const f32x4*)(sinT + (size_t)tok * 32 + j0), s1 = *(const f32x4*)(sinT + (size_t)tok * 32 + j0 + 4);
        float o1[8], o2[8];
#pragma unroll
        for (int e = 0; e < 8; ++e) { const float a = bf2f((unsigned short)x1[e]), bb = bf2f((unsigned short)x2[e]);
            const float cs = e < 4 ? c0[e & 3] : c1[e & 3], sn = e < 4 ? s0[e & 3] : s1[e & 3];
            o1[e] = a * cs - bb * sn; o2[e] = a * sn + bb * cs; }
        u32x4 w1 = {cvtpk(o1[0], o1[1]), cvtpk(o1[2], o1[3]), cvtpk(o1[4], o1[5]), cvtpk(o1[6], o1[7])};
        u32x4 w2 = {cvtpk(o2[0], o2[1]), cvtpk(o2[2], o2[3]), cvtpk(o2[4], o2[5]), cvtpk(o2[6], o2[7])};
        qr[8 + dd] = __builtin_bit_cast(bf16x8, w1); qr[10 + dd] = __builtin_bit_cast(bf16x8, w2);
    }
    int kst[3], vst[3];
#pragma unroll
    for (int i = 0; i < 3; ++i) { const int id = tid + 512 * i, row = id / 24, ch = id - row * 24;
        kst[i] = KSWZ(row, ch * 16); vst[i] = ch < 16 ? v_st(row, ch * 8) : -1; }
    const char* Kg = (const char*)(Kb + (size_t)b * SEQ * 192);
    const int NT = c + 1;
    bf16x8 st[3];
#define SLOAD(j) do { _Pragma("unroll") for (int i_ = 0; i_ < 3; ++i_) st[i_] = *(const bf16x8*)(Kg + (size_t)(j) * SHM_K + (size_t)(tid + 512 * i_) * 16); } while (0)
#define SWRITE(bf) do { _Pragma("unroll") for (int i_ = 0; i_ < 3; ++i_) { *(bf16x8*)(K_lds + (bf) * SHM_K + kst[i_]) = st[i_]; \
        if (vst[i_] >= 0) *(bf16x8*)(V_lds + (bf) * SHM_V + vst[i_]) = st[i_]; } } while (0)
    float m_reg = -1e30f, l_reg = 0.f;
    f32x16 o[4];
#pragma unroll
    for (int d = 0; d < 4; ++d)
#pragma unroll
        for (int r = 0; r < 16; ++r) o[d][r] = 0.f;
    const int vb0 = (int)(uintptr_t)V_lds + v_rd_base(lane);
    SLOAD(0); SWRITE(0);
    if (NT > 1) SLOAD(1);
    for (int j = 0; j < NT; ++j) {
        __syncthreads();
        const int cur = j & 1;
        if (j + 1 < NT) { SWRITE(cur ^ 1); if (j + 2 < NT) SLOAD(j + 2); }
        f32x16 p0, p1; float mn, alpha; bf16x8 pa0, pa1, pa2, pa3;
        qkt(p0, p1, K_lds + cur * SHM_K, qr, r32, hi);
        partialSM(p0, p1, m_reg, mn, alpha);
        if (__any(alpha < 1.f)) {
            if (hi == 0) al_l[r32] = alpha;
            asm volatile("s_waitcnt lgkmcnt(0)" ::: "memory");
#pragma unroll
            for (int d = 0; d < 4; ++d)
#pragma unroll
                for (int r = 0; r < 16; ++r) o[d][r] *= al_l[crow(r, hi)];
        }
        finishSM(p0, p1, alpha, l_reg, pa0, pa1, pa2, pa3);
        const int vb = vb0 + cur * SHM_V;
        pv_one<0>(o[0], vb, pa0, pa1, pa2, pa3); pv_one<1>(o[1], vb, pa0, pa1, pa2, pa3); pv_one<2>(o[2], vb, pa0, pa1, pa2, pa3); pv_one<3>(o[3], vb, pa0, pa1, pa2, pa3);
    }
    if (hi == 0) li_l[r32] = l_reg;
    asm volatile("s_waitcnt lgkmcnt(0)" ::: "memory");
    int tid2 = threadIdx.x; asm volatile("" : "+v"(tid2));
    bf16_t* orow = amix + (size_t)(b * SEQ + c * 64 + ((tid2 >> 6) & 1) * 32) * 1024 + (tid2 >> 7) * 128 + (tid2 & 31);
#pragma unroll
    for (int r = 0; r < 16; ++r) { const int qq = crow(r, hi); const float rl = __builtin_amdgcn_rcpf(li_l[qq]);
#pragma unroll
        for (int d0 = 0; d0 < 4; ++d0) orow[(size_t)qq * 1024 + d0 * 32] = (bf16_t)(cvtpk(o[d0][r] * rl, 0.f) & 0xffffu); }
    __syncthreads();
#undef SLOAD
#undef SWRITE
}
DI void attn_phase(const Params& p, char* lds) {
    const bf16_t* qp = (const bf16_t*)(p.ws + WS_QP); const bf16_t* kb = (const bf16_t*)(p.ws + WS_KB);
    const float* cosT = (const float*)(p.ws + WS_COS); const float* sinT = (const float*)(p.ws + WS_SIN);
    bf16_t* amix = (bf16_t*)(p.ws + WS_AMIX);
    for (int u = blockIdx.x; u < 256; u += gridDim.x) {
        const int b = u & 7, cp = u >> 3;
#pragma unroll 1
        for (int half = 0; half < 2; ++half) attn_unit(b, half ? cp : 63 - cp, qp, kb, cosT, sinT, amix, lds);
    }
}
}

DI void final_norm_phase(float* X, const float* g) {
    const int tid = otid(), lane = tid & 63, gw = blockIdx.x * 8 + (tid >> 6), nw = gridDim.x * 8;
    f32x4 gg[4];
#pragma unroll
    for (int i = 0; i < 4; ++i) gg[i] = *(const f32x4*)(g + i * 256 + lane * 4);
    for (int base = gw * 16; base < M_TOK; base += nw * 16) {
#pragma unroll 1
        for (int r0 = 0; r0 < 16; r0 += 4) {
            f32x4 v[4][4]; float ss[4];
#pragma unroll
            for (int rr = 0; rr < 4; ++rr)
#pragma unroll
                for (int i = 0; i < 4; ++i) v[rr][i] = *(const f32x4*)(X + (size_t)(base + r0 + rr) * DM + i * 256 + lane * 4);
#pragma unroll
            for (int rr = 0; rr < 4; ++rr) { float a = 0.f;
#pragma unroll
                for (int i = 0; i < 4; ++i) a += v[rr][i][0] * v[rr][i][0] + v[rr][i][1] * v[rr][i][1] + v[rr][i][2] * v[rr][i][2] + v[rr][i][3] * v[rr][i][3];
                ss[rr] = a; }
#pragma unroll
            for (int rr = 0; rr < 4; ++rr) ss[rr] = wave_sum(ss[rr]);
#pragma unroll
            for (int rr = 0; rr < 4; ++rr) { const float rstd = 1.0f / sqrtf(ss[rr] * (1.0f / DM) + EPS);
#pragma unroll
                for (int i = 0; i < 4; ++i) *(f32x4*)(X + (size_t)(base + r0 + rr) * DM + i * 256 + lane * 4) = v[rr][i] * rstd * gg[i]; }
        }
    }
}

#ifndef PROBE_DUP
#define PROBE_DUP 0
#endif
__global__ void __launch_bounds__(NTHREADS, 2) mla_block_fwd(Params p) {
    extern __shared__ __attribute__((aligned(16))) unsigned char lds[];
    cg::grid_group grid = cg::this_grid();
    const int G = gridDim.x, bx = blockIdx.x;
    const float* mod = (const float*)(p.ws + WS_MOD);
    bf16_t* H = (bf16_t*)(p.ws + WS_H);
    PG8_LAS unsigned char* ring = (PG8_LAS unsigned char*)lds;

#define REP(k) for (int rep_ = 0; rep_ < 1 + ((PROBE_DUP >> (k)) & 1); ++rep_)
    REP(0) { p0_prep(p, (float*)lds); grid.sync(); }
    REP(1) { norm_mod_phase(p.x, p.g_mix, mod, 0 * DM, 1 * DM, H); grid.sync(); }
    REP(2) { pg8::Gemm g{H, (const bf16_t*)(p.ws + WS_WIN), M_TOK, 1024, 1024}; pg8::StaticOrder S; S.init(M_TOK, 1024, G, bx);
      pg8::EpiStoreBf16 E{(bf16_t*)(p.ws + WS_PROJ), 1024};
      pg8::gemm_phase<pg8::EpiStoreBf16, pg8::StaticOrder, true, true>(ring, g, S, E); grid.sync(); }
    REP(3) { post_proj_phase(p); grid.sync(); }
    REP(4) { pg8::Gemm g{(const bf16_t*)(p.ws + WS_CQ), (const bf16_t*)(p.ws + WS_WQ), M_TOK, 768, 256}; pg8::StaticOrder S; S.init(M_TOK, 768, G, bx);
      pg8::EpiStoreBf16 E{(bf16_t*)(p.ws + WS_QP), 768};
      pg8::gemm_phase<pg8::EpiStoreBf16, pg8::StaticOrder, true, true>(ring, g, S, E); grid.sync(); }
    REP(5) { att::attn_phase(p, (char*)lds); grid.sync(); }
    REP(6) { pg8::Gemm g{(const bf16_t*)(p.ws + WS_AMIX), (const bf16_t*)(p.ws + WS_WMIX), M_TOK, 1024, 1024}; pg8::StaticOrder S; S.init(M_TOK, 1024, G, bx);
      pg8::EpiResid E{p.x, p.out, mod + 2 * DM};
      pg8::gemm_phase<pg8::EpiResid, pg8::StaticOrder, true, true>(ring, g, S, E); grid.sync(); }
    REP(7) { norm_mod_phase(p.out, p.g_ffn, mod, 3 * DM, 4 * DM, H); grid.sync(); }
    REP(8) { pg8::Gemm g{H, (const bf16_t*)(p.ws + WS_WGU), M_TOK, 2 * DFF, 1024}; pg8::StaticOrder S; S.init(M_TOK, 2 * DFF, G, bx);
      pg8::EpiSwiGLU E{(bf16_t*)(p.ws + WS_ACT), DFF};
      pg8::gemm_phase<pg8::EpiSwiGLU, pg8::StaticOrder, true, true>(ring, g, S, E); grid.sync(); }
    { pg8::Gemm g{(const bf16_t*)(p.ws + WS_ACT), (const bf16_t*)(p.ws + WS_WDN), M_TOK, 1024, DFF}; pg8::StaticOrder S; S.init(M_TOK, 1024, G, bx);
      pg8::EpiResid E{p.out, p.out, mod + 5 * DM};
      pg8::gemm_phase<pg8::EpiResid, pg8::StaticOrder, true, true>(ring, g, S, E); grid.sync(); }
    final_norm_phase(p.out, p.g_final);
}

extern "C" void kernel_launch(void* const* d_in, const int* in_sizes, int n_in, void* d_out, int out_size, void* d_ws, size_t ws_size, hipStream_t stream) {
    static int grid_blocks = 0;
    if (!grid_blocks) {
        if (n_in != 20 || out_size != M_TOK * DM || ws_size < WS_END) { fprintf(stderr, "kernel_launch: unexpected shapes n_in %d out %d ws %zu\n", n_in, out_size, ws_size); return; }
        if (hipFuncSetAttribute((const void*)mla_block_fwd, hipFuncAttributeMaxDynamicSharedMemorySize, LDS_BYTES) != hipSuccess) { fprintf(stderr, "kernel_launch: hipFuncSetAttribute failed\n"); return; }
        int dev = 0, cus = 0, per_cu = 0;
        hipGetDevice(&dev);
        hipDeviceGetAttribute(&cus, hipDeviceAttributeMultiprocessorCount, dev);
        if (hipOccupancyMaxActiveBlocksPerMultiprocessor(&per_cu, (const void*)mla_block_fwd, NTHREADS, LDS_BYTES) != hipSuccess || per_cu < 1) { fprintf(stderr, "kernel_launch: occupancy query failed\n"); return; }
        grid_blocks = cus * 1;
    }
    Params p{};
    p.x = (const float*)d_in[0]; p.c = (const float*)d_in[1]; p.pos = (const int*)d_in[2]; p.w_ada = (const float*)d_in[3]; p.b_ada = (const float*)d_in[4];
    p.g_mix = (const float*)d_in[5]; p.w_in = (const float*)d_in[6]; p.g_q = (const float*)d_in[7]; p.g_kv = (const float*)d_in[8]; p.w_uq = (const float*)d_in[9];
    p.w_uk = (const float*)d_in[10]; p.w_uv = (const float*)d_in[11]; p.w_pool = (const float*)d_in[12]; p.pool_scale = (const float*)d_in[13]; p.w_o = (const float*)d_in[14];
    p.g_ffn = (const float*)d_in[15]; p.w_gate = (const float*)d_in[16]; p.w_up = (const float*)d_in[17]; p.w_down = (const float*)d_in[18]; p.g_final = (const float*)d_in[19];
    p.out = (float*)d_out; p.ws = (unsigned char*)d_ws;
    void* args[] = {&p};
    hipError_t e = hipLaunchCooperativeKernel((const void*)mla_block_fwd, dim3(grid_blocks), dim3(NTHREADS), args, LDS_BYTES, stream);
    if (e != hipSuccess) fprintf(stderr, "kernel_launch: cooperative launch failed: %s (grid %d)\n", hipGetErrorString(e), grid_blocks);
}
```

```cpp
#include <hip/hip_runtime.h>
#include <hip/hip_cooperative_groups.h>
#include <cstdio>
#include <cstdint>
namespace cg = cooperative_groups;
namespace pg8 {
#define PG8_LAS __attribute__((address_space(3)))
typedef unsigned short bf16_t;
typedef short bf16x8 __attribute__((ext_vector_type(8)));
typedef float f32x4 __attribute__((ext_vector_type(4)));
typedef unsigned u32x4 __attribute__((ext_vector_type(4)));
constexpr int BM = 256, BK = 64, HALF = 128, HTB = HALF * BK * 2  , STAGE_BYTES = 8 * HTB, NXCD = 8, WGM = 8;

__host__ __device__ __forceinline__ int lds_byte(int r, int c) { const int st = (r >> 4) * 2 + (c >> 5), rr = r & 15, cc = c & 31, ob = rr * 64 + cc * 2; return st * 1024 + (ob ^ (((ob >> 9) & 1) << 5)); }
__host__ __device__ __forceinline__ void stage_rc(int b, int& R, int& C) { const int st = b / 1024, sb = b % 1024, swz = sb ^ (((sb >> 9) & 1) << 5); R = (st >> 1) * 16 + swz / 64; C = (st & 1) * 32 + (swz % 64) / 2; }
__host__ __device__ __forceinline__ int perm32(int rho) { const int n = rho >> 4, i = rho & 15; return 8 * (i >> 2) + 4 * n + (i & 3); }

struct Unit { int pm, pn; };
struct Gemm { const bf16_t* A; const bf16_t* Bt; int M, N, K; };

struct StaticOrder {
    int nM, nN, nwg, G, c;
    __host__ __device__ void init(int M, int N, int G_, int c_) { nM = M / BM; nN = N / BM; nwg = nM * nN; G = G_; c = c_; }
    __host__ __device__ bool next(int i, Unit& u) const {
        const long L = (long)i * G + c; if (L >= nwg) return false;
        int wgid = (int)L; { const int q = nwg / NXCD, r = nwg % NXCD, xcd = wgid % NXCD, off = wgid / NXCD; wgid = (xcd < r ? xcd * (q + 1) : r * (q + 1) + (xcd - r) * q) + off; }
        const int nig = WGM * nN, gid = wgid / nig, fm = gid * WGM, gsz = (nM - fm) < WGM ? (nM - fm) : WGM;
        u.pm = fm + ((wgid % nig) % gsz); u.pn = (wgid % nig) / gsz; return true;
    }
    __device__ __forceinline__ void a_ready(const Unit&) const {}
    __device__ __forceinline__ void done(const Unit&) const {}
};

__device__ __forceinline__ unsigned cvt_pk_bf16(float lo, float hi) { unsigned r; asm volatile("v_cvt_pk_bf16_f32 %0, %1, %2" : "=v"(r) : "v"(lo), "v"(hi)); return r; }

struct EpiStoreBf16 {
    static constexpr bool PERM = true, AFTER_DRAIN = false;
    bf16_t* O; int ldc;
    __device__ __forceinline__ void operator()(const f32x4 (&acc)[2][2][4][2], const Unit& u, int wr, int wc, int fr, int fq) const {
        const int row0 = u.pm * BM + wr * 64 + fr, col0 = u.pn * BM + wc * 32 + 8 * fq;
#pragma unroll
        for (int ai = 0; ai < 2; ++ai)
#pragma unroll
            for (int m = 0; m < 4; ++m) { bf16_t* rowp = O + (size_t)(row0 + ai * HALF + m * 16) * ldc + col0;
#pragma unroll
                for (int bj = 0; bj < 2; ++bj) { const f32x4 v0 = acc[ai][bj][m][0], v1 = acc[ai][bj][m][1];
                    u32x4 w; w.x = cvt_pk_bf16(v0[0], v0[1]); w.y = cvt_pk_bf16(v0[2], v0[3]); w.z = cvt_pk_bf16(v1[0], v1[1]); w.w = cvt_pk_bf16(v1[2], v1[3]);
                    *(u32x4*)(rowp + bj * HALF) = w; } }
    }
};
struct EpiResid {
    static constexpr bool PERM = true, AFTER_DRAIN = false;
    const float* X; float* Out; const float* gate;
    __device__ __forceinline__ void operator()(const f32x4 (&acc)[2][2][4][2], const Unit& u, int wr, int wc, int fr, int fq) const {
        const int row0 = u.pm * BM + wr * 64 + fr, col0 = u.pn * BM + wc * 32 + 8 * fq;
        const float* gp = gate + (size_t)((u.pm * BM) >> 12) * 6144 + col0;
        f32x4 gv[2][2];
#pragma unroll
        for (int bj = 0; bj < 2; ++bj)
#pragma unroll
            for (int n = 0; n < 2; ++n) gv[bj][n] = *(const f32x4*)(gp + bj * HALF + 4 * n);
#pragma unroll
        for (int ai = 0; ai < 2; ++ai)
#pragma unroll
            for (int m = 0; m < 4; ++m) { const size_t ro = (size_t)(row0 + ai * HALF + m * 16) * 1024 + col0;
#pragma unroll
                for (int bj = 0; bj < 2; ++bj) {
                    const f32x4 x0 = *(const f32x4*)(X + ro + bj * HALF), x1 = *(const f32x4*)(X + ro + bj * HALF + 4);
                    const f32x4 o0 = x0 + gv[bj][0] * acc[ai][bj][m][0], o1 = x1 + gv[bj][1] * acc[ai][bj][m][1];
                    *(f32x4*)(Out + ro + bj * HALF) = o0; *(f32x4*)(Out + ro + bj * HALF + 4) = o1; } }
    }
};
struct EpiSwiGLU {
    static constexpr bool PERM = true, AFTER_DRAIN = false;
    bf16_t* O; int ldc;
    __device__ __forceinline__ void operator()(const f32x4 (&acc)[2][2][4][2], const Unit& u, int wr, int wc, int fr, int fq) const {
        const int row0 = u.pm * BM + wr * 64 + fr, col0 = u.pn * HALF + wc * 32 + 8 * fq;
#pragma unroll
        for (int ai = 0; ai < 2; ++ai)
#pragma unroll
            for (int m = 0; m < 4; ++m) { bf16_t* rowp = O + (size_t)(row0 + ai * HALF + m * 16) * ldc + col0;
                float a[8];
#pragma unroll
                for (int n = 0; n < 2; ++n)
#pragma unroll
                    for (int e = 0; e < 4; ++e) { const float g = acc[ai][0][m][n][e], up = acc[ai][1][m][n][e];
                        a[4 * n + e] = g * __builtin_amdgcn_rcpf(1.0f + __expf(-g)) * up; }
                u32x4 w; w.x = cvt_pk_bf16(a[0], a[1]); w.y = cvt_pk_bf16(a[2], a[3]); w.z = cvt_pk_bf16(a[4], a[5]); w.w = cvt_pk_bf16(a[6], a[7]);
                *(u32x4*)rowp = w; }
    }
};

template <class Epi, class Sched, bool ALIGN_EPI = false, bool SP2 = false>
__device__ __forceinline__ void gemm_phase(PG8_LAS unsigned char* lds, const Gemm g, const Sched& S, const Epi& E) {
    int tid_ = threadIdx.x; asm volatile("" : "+v"(tid_));
    const int tid = tid_, wid = __builtin_amdgcn_readfirstlane(tid >> 6), lane = tid & 63, wr = wid >> 2, wc = wid & 3, fr = lane & 15, fq = lane >> 4;
    const int K = g.K, nt = K / BK;
    unsigned voffA[2], voffB[2];
#pragma unroll
    for (int i = 0; i < 2; ++i) { int R, C; stage_rc(tid * 16 + i * 8192, R, C); const int Rb = Epi::PERM ? ((R & ~31) + perm32(R & 31)) : R;
        voffA[i] = (unsigned)(R * K + C) * 2u; voffB[i] = (unsigned)(Rb * K + C) * 2u; }
    const size_t kstep = (size_t)(BK * 2);
    const size_t hstep = (size_t)HALF * K * 2;
    const size_t tstep = 2 * hstep;
    const unsigned ldsw = (unsigned)wid * 1024u;
    const int aoff = lds_byte(wr * 64 + fr, fq * 8), boff = lds_byte(wc * 32 + fr, fq * 8);
#define PG8_SA(b, h) (((b) * 2 + (h)) * HTB)
#define PG8_SB(b, h) ((4 + (b) * 2 + (h)) * HTB)
#define PG8_STAGE(bufoff, gbase, voff) do { _Pragma("unroll") for (int _i = 0; _i < 2; ++_i) \
        __builtin_amdgcn_global_load_lds((const unsigned*)((const char*)(gbase) + (voff)[_i]), (PG8_LAS unsigned*)(lds + (bufoff) + ldsw + _i * 8192), 16, 0, 0); } while (0)
#define PG8_LDA(dst, b, h) do { _Pragma("unroll") for (int m = 0; m < 4; ++m) _Pragma("unroll") for (int k = 0; k < 2; ++k) dst[m][k] = *(const PG8_LAS bf16x8*)(lds + PG8_SA(b, h) + aoff + m * 2048 + k * 1024); } while (0)
#define PG8_LDB(dst, b, h) do { _Pragma("unroll") for (int n = 0; n < 2; ++n) _Pragma("unroll") for (int k = 0; k < 2; ++k) dst[n][k] = *(const PG8_LAS bf16x8*)(lds + PG8_SB(b, h) + boff + n * 2048 + k * 1024); } while (0)
#define PG8_MMA(ai, bj, At, Bt) do { __builtin_amdgcn_s_setprio(1); _Pragma("unroll") for (int m = 0; m < 4; ++m) _Pragma("unroll") for (int n = 0; n < 2; ++n) _Pragma("unroll") for (int k = 0; k < 2; ++k) \
        acc[ai][bj][m][n] = __builtin_amdgcn_mfma_f32_16x16x32_bf16(Bt[n][k], At[m][k], acc[ai][bj][m][n], 0, 0, 0); __builtin_amdgcn_s_setprio(0); } while (0)
#define PG8_WAIT_V(n) asm volatile("s_waitcnt vmcnt(" #n ")" ::: "memory")
#define PG8_WAIT_L(n) asm volatile("s_waitcnt lgkmcnt(" #n ")" ::: "memory")
#define PG8_BAR __builtin_amdgcn_s_barrier()
#define PG8_SCHED __builtin_amdgcn_sched_barrier(0)
    Unit cur, nxt; int ui = 0;
    if (!S.next(0, cur)) return;
    f32x4 acc[2][2][4][2];
#pragma unroll
    for (int a = 0; a < 2; ++a)
#pragma unroll
        for (int b = 0; b < 2; ++b)
#pragma unroll
            for (int m = 0; m < 4; ++m)
#pragma unroll
                for (int n = 0; n < 2; ++n) acc[a][b][m][n] = (f32x4){0.f, 0.f, 0.f, 0.f};
    bf16x8 At[4][2], B0[2][2], B1[2][2];
    const char* cA = (const char*)g.A + (size_t)cur.pm * tstep; const char* cB = (const char*)g.Bt + (size_t)cur.pn * tstep;
    S.a_ready(cur);
    if constexpr (SP2) {
        PG8_STAGE(PG8_SB(0, 0), cB, voffB); PG8_STAGE(PG8_SB(0, 1), cB + hstep, voffB); PG8_STAGE(PG8_SA(0, 0), cA, voffA); PG8_STAGE(PG8_SA(0, 1), cA + hstep, voffA);
        if (wr == 1) PG8_BAR;
        PG8_WAIT_V(2); PG8_BAR;
        PG8_STAGE(PG8_SB(1, 0), cB + kstep, voffB); PG8_STAGE(PG8_SA(1, 0), cA + kstep, voffA); PG8_STAGE(PG8_SB(1, 1), cB + hstep + kstep, voffB);
        PG8_WAIT_V(6); PG8_BAR;
    } else {
        PG8_STAGE(PG8_SB(0, 0), cB, voffB); PG8_STAGE(PG8_SA(0, 0), cA, voffA); PG8_STAGE(PG8_SB(0, 1), cB + hstep, voffB); PG8_STAGE(PG8_SA(0, 1), cA + hstep, voffA);
        if (wr == 1) PG8_BAR;
        PG8_WAIT_V(4); PG8_BAR;
        PG8_STAGE(PG8_SB(1, 0), cB + kstep, voffB); PG8_STAGE(PG8_SA(1, 0), cA + kstep, voffA); PG8_STAGE(PG8_SB(1, 1), cB + hstep + kstep, voffB);
        PG8_WAIT_V(6); PG8_BAR;
    }
    for (;;) {
        const bool has_next = S.next(ui + 1, nxt);
        const char* nA = has_next ? (const char*)g.A + (size_t)nxt.pm * tstep : cA; const char* nB = has_next ? (const char*)g.Bt + (size_t)nxt.pn * tstep : cB;
        for (int t = 0; t < nt; t += 2) {
            const bool last = (t == nt - 2);
            const char* a1 = cA + (size_t)(t + 1) * kstep;
            const char* a2 = last ? nA : cA + (size_t)(t + 2) * kstep; const char* b2 = last ? nB : cB + (size_t)(t + 2) * kstep;
            const char* a3 = a2 + kstep; const char* b3 = b2 + kstep;
            if (last && has_next) S.a_ready(nxt);
            if constexpr (SP2) {
            PG8_LDB(B0, 0, 0); PG8_LDB(B1, 0, 1); PG8_SCHED; PG8_LDA(At, 0, 0); PG8_STAGE(PG8_SA(1, 1), a1 + hstep, voffA);
            PG8_WAIT_V(8); PG8_WAIT_L(0); PG8_BAR; PG8_MMA(0, 0, At, B0); PG8_MMA(0, 1, At, B1); PG8_BAR; PG8_SCHED;
            PG8_LDA(At, 0, 1); PG8_STAGE(PG8_SB(0, 0), b2, voffB); PG8_STAGE(PG8_SB(0, 1), b2 + hstep, voffB); PG8_STAGE(PG8_SA(0, 0), a2, voffA);
            PG8_WAIT_V(8); PG8_WAIT_L(0); PG8_BAR; PG8_MMA(1, 0, At, B0); PG8_MMA(1, 1, At, B1); PG8_BAR; PG8_SCHED;
            PG8_LDB(B0, 1, 0); PG8_LDB(B1, 1, 1); PG8_SCHED; PG8_LDA(At, 1, 0); PG8_STAGE(PG8_SA(0, 1), a2 + hstep, voffA);
            PG8_WAIT_V(8); PG8_WAIT_L(0); PG8_BAR; PG8_MMA(0, 0, At, B0); PG8_MMA(0, 1, At, B1); PG8_BAR; PG8_SCHED;
            PG8_LDA(At, 1, 1); PG8_STAGE(PG8_SB(1, 0), b3, voffB); PG8_STAGE(PG8_SB(1, 1), b3 + hstep, voffB); PG8_STAGE(PG8_SA(1, 0), a3, voffA);
            PG8_WAIT_V(8); PG8_WAIT_L(0); PG8_BAR; PG8_MMA(1, 0, At, B0); PG8_MMA(1, 1, At, B1); PG8_BAR; PG8_SCHED;
            } else {
            PG8_LDB(B0, 0, 0); PG8_SCHED; PG8_LDA(At, 0, 0); PG8_STAGE(PG8_SA(1, 1), a1 + hstep, voffA);
            PG8_WAIT_L(8); PG8_BAR; PG8_WAIT_L(0); PG8_MMA(0, 0, At, B0); PG8_BAR; PG8_SCHED;
            PG8_LDB(B1, 0, 1); PG8_STAGE(PG8_SB(0, 0), b2, voffB);
            PG8_BAR; PG8_WAIT_L(0); PG8_MMA(0, 1, At, B1); PG8_BAR;
            PG8_LDA(At, 0, 1); PG8_STAGE(PG8_SA(0, 0), a2, voffA);
            PG8_BAR; PG8_WAIT_L(0); PG8_MMA(1, 0, At, B0); PG8_BAR; PG8_SCHED;
            PG8_STAGE(PG8_SB(0, 1), b2 + hstep, voffB);
            PG8_WAIT_V(6); PG8_BAR; PG8_MMA(1, 1, At, B1); PG8_BAR;
            PG8_LDB(B0, 1, 0); PG8_SCHED; PG8_LDA(At, 1, 0); PG8_STAGE(PG8_SA(0, 1), a2 + hstep, voffA);
            PG8_WAIT_L(8); PG8_BAR; PG8_WAIT_L(0); PG8_MMA(0, 0, At, B0); PG8_BAR; PG8_SCHED;
            PG8_LDB(B1, 1, 1); PG8_STAGE(PG8_SB(1, 0), b3, voffB);
            PG8_BAR; PG8_WAIT_L(0); PG8_MMA(0, 1, At, B1); PG8_BAR;
            PG8_LDA(At, 1, 1); PG8_STAGE(PG8_SA(1, 0), a3, voffA);
            PG8_BAR; PG8_WAIT_L(0); PG8_MMA(1, 0, At, B0); PG8_BAR; PG8_SCHED;
            PG8_STAGE(PG8_SB(1, 1), b3 + hstep, voffB);
            PG8_WAIT_V(6); PG8_BAR; PG8_MMA(1, 1, At, B1); PG8_BAR;
            }
        }
        if constexpr (ALIGN_EPI) { if (wr == 0) PG8_BAR; }
        if constexpr (!Epi::AFTER_DRAIN) { E(acc, cur, wr, wc, fr, fq); S.done(cur); }
        if (!has_next) break;
#pragma unroll
        for (int a = 0; a < 2; ++a)
#pragma unroll
            for (int b = 0; b < 2; ++b)
#pragma unroll
                for (int m = 0; m < 4; ++m)
#pragma unroll
                    for (int n = 0; n < 2; ++n) acc[a][b][m][n] = (f32x4){0.f, 0.f, 0.f, 0.f};
        cur = nxt; cA = nA; cB = nB; ++ui;
        if constexpr (ALIGN_EPI) { if (wr == 1) PG8_BAR; }
    }
    PG8_WAIT_V(0);
    if constexpr (!ALIGN_EPI) { if (wr == 0) PG8_BAR; }
    PG8_BAR;
    if constexpr (Epi::AFTER_DRAIN) { E.fused(acc, cur, wr, wc, fr, fq, lds, wid, lane); S.done(cur); }
#undef PG8_SA
#undef PG8_SB
#undef PG8_STAGE
#undef PG8_LDA
#undef PG8_LDB
#undef PG8_MMA
#undef PG8_WAIT_V
#undef PG8_WAIT_L
#undef PG8_BAR
#undef PG8_SCHED
}
}

typedef unsigned short bf16_t;
typedef short bf16x8 __attribute__((ext_vector_type(8)));
typedef short s16x4 __attribute__((ext_vector_type(4)));
typedef float f32x4 __attribute__((ext_vector_type(4)));
typedef float f32x16 __attribute__((ext_vector_type(16)));
typedef unsigned u32x4 __attribute__((ext_vector_type(4)));
typedef unsigned u32x2 __attribute__((ext_vector_type(2)));
#define DI __device__ __forceinline__

constexpr int M_TOK = 32768, DM = 1024, SEQ = 4096, NB = 8, DFF = 2816, NMOD = 6144;
constexpr float EPS = 1e-6f;
constexpr int NTHREADS = 512;

constexpr size_t MiB = 1u << 20;
constexpr size_t WS_MOD = 0;
constexpr size_t WS_BAR = 512 * 1024, BAR_BYTES = 16384;
constexpr size_t WS_COS = 1 * MiB, WS_SIN = 5 * MiB;
constexpr size_t WS_WIN = 16 * MiB;
constexpr size_t WS_WQ = 18 * MiB;
constexpr size_t WS_WMIX = 19 * MiB;
constexpr size_t WS_WGU = 21 * MiB;
constexpr size_t WS_WDN = 32 * MiB;
constexpr size_t WS_H = 64 * MiB;
constexpr size_t WS_ACT = 128 * MiB;
constexpr size_t WS_PROJ = 128 * MiB;
constexpr size_t WS_AMIX = 192 * MiB;
constexpr size_t WS_QP = 256 * MiB;
constexpr size_t WS_CQ = 304 * MiB;
constexpr size_t WS_KB = 320 * MiB;
constexpr size_t WS_END = 332 * MiB;

constexpr int LDS_BYTES = 135168;

struct Params {
    const float* x; const float* c; const int* pos; const float* w_ada; const float* b_ada; const float* g_mix; const float* w_in;
    const float* g_q; const float* g_kv; const float* w_uq; const float* w_uk; const float* w_uv; const float* w_pool; const float* pool_scale;
    const float* w_o; const float* g_ffn; const float* w_gate; const float* w_up; const float* w_down; const float* g_final;
    float* out; unsigned char* ws;
    int use_cg_sync; int pad;
};

DI float bf2f(unsigned short h) { return __uint_as_float((unsigned)h << 16); }
DI unsigned cvtpk(float lo, float hi) { unsigned r; asm volatile("v_cvt_pk_bf16_f32 %0, %1, %2" : "=v"(r) : "v"(lo), "v"(hi)); return r; }
DI int otid() { int t = threadIdx.x; asm volatile("" : "+v"(t)); return t; }
DI float wave_sum(float v) {
#pragma unroll
    for (int o = 32; o >= 1; o >>= 1) v += __shfl_xor(v, o);
    return v;
}

constexpr int N_FMIX = 128, N_ADA = 192, N_FQ = 64, N_TR_IN = 64, N_TR_G = 176, N_TR_U = 176, N_TR_D = 176;
constexpr int N_ITEMS = N_FMIX + N_ADA + N_FQ + N_TR_IN + N_TR_G + N_TR_U + N_TR_D;

DI void p0_fold_mix(const Params& p, int item, float* lds) {
    const int tid = otid(), blk = item >> 4, nt = item & 15;
    float* L = lds;
    float* Wo = lds + 128 * 132;
    for (int i = tid; i < 128 * 32; i += NTHREADS) {
        const int cc = i >> 5, v4 = (i & 31) * 4;
        f32x4 v;
        if (blk < 4) v = *(const f32x4*)(p.w_uv + (size_t)(cc * 4 + blk) * 128 + v4);
        else { const int g = blk - 4; v = *(const f32x4*)(p.w_pool + (size_t)(g * 128 + cc) * 128 + v4) * *(const f32x4*)(p.pool_scale + g * 128 + v4); }
        *(f32x4*)(L + cc * 132 + v4) = v;
    }
    for (int i = tid; i < 128 * 16; i += NTHREADS) {
        const int v = i >> 4, n4 = (i & 15) * 4;
        *(f32x4*)(Wo + v * 64 + n4) = *(const f32x4*)(p.w_o + (size_t)(blk * 128 + v) * 1024 + nt * 64 + n4);
    }
    __syncthreads();
    const int n = tid & 63, ccg = tid >> 6;
    float acc[16];
#pragma unroll
    for (int i = 0; i < 16; ++i) acc[i] = 0.f;
    for (int v4 = 0; v4 < 128; v4 += 4) {
        const float w0 = Wo[(v4 + 0) * 64 + n], w1 = Wo[(v4 + 1) * 64 + n], w2 = Wo[(v4 + 2) * 64 + n], w3 = Wo[(v4 + 3) * 64 + n];
#pragma unroll
        for (int i = 0; i < 16; ++i) { const f32x4 l = *(const f32x4*)(L + (ccg * 16 + i) * 132 + v4);
            acc[i] = fmaf(l[0], w0, acc[i]); acc[i] = fmaf(l[1], w1, acc[i]); acc[i] = fmaf(l[2], w2, acc[i]); acc[i] = fmaf(l[3], w3, acc[i]); }
    }
    bf16_t* dst = (bf16_t*)(p.ws + WS_WMIX) + (size_t)(nt * 64 + n) * 1024 + blk * 128 + ccg * 16;
    u32x4 w0, w1;
    w0.x = cvtpk(acc[0], acc[1]); w0.y = cvtpk(acc[2], acc[3]); w0.z = cvtpk(acc[4], acc[5]); w0.w = cvtpk(acc[6], acc[7]);
    w1.x = cvtpk(acc[8], acc[9]); w1.y = cvtpk(acc[10], acc[11]); w1.z = cvtpk(acc[12], acc[13]); w1.w = cvtpk(acc[14], acc[15]);
    *(u32x4*)dst = w0; *(u32x4*)(dst + 8) = w1;
    __syncthreads();
}

DI void p0_ada(const Params& p, int item, float* lds) {
    const int tid = otid(), n0 = item * 32, col = tid & 31, kg = tid >> 5;
    float* cact = lds;
    float* red = lds + 8192;
    for (int i = tid; i < 8192; i += NTHREADS) { const float v = p.c[i]; cact[i] = v / (1.0f + __expf(-v)); }
    __syncthreads();
    float acc[8];
#pragma unroll
    for (int b = 0; b < 8; ++b) acc[b] = 0.f;
    const float* wp = p.w_ada + (size_t)(kg * 64) * NMOD + n0 + col;
#pragma unroll 16
    for (int kk = 0; kk < 64; ++kk) {
        const float w = wp[(size_t)kk * NMOD];
#pragma unroll
        for (int b = 0; b < 8; ++b) acc[b] = fmaf(cact[b * 1024 + kg * 64 + kk], w, acc[b]);
    }
#pragma unroll
    for (int b = 0; b < 8; ++b) red[(kg * 8 + b) * 32 + col] = acc[b];
    __syncthreads();
    if (tid < 256) {
        const int b = tid >> 5; float s = 0.f;
#pragma unroll
        for (int g = 0; g < 16; ++g) s += red[(g * 8 + b) * 32 + col];
        ((float*)(p.ws + WS_MOD))[b * NMOD + n0 + col] = s + p.b_ada[n0 + col];
    }
    __syncthreads();
}

DI void p0_fold_q(const Params& p, int item, float* lds) {
    const int tid = otid(), h = item >> 4, r0 = (item & 15) * 16;
    float* Bs = lds;
    float* As = lds + 128 * 132;
    for (int i = tid; i < 128 * 32; i += NTHREADS) { const int cc = i >> 5, d4 = (i & 31) * 4;
        *(f32x4*)(Bs + cc * 132 + d4) = *(const f32x4*)(p.w_uk + (size_t)(cc * 4 + h) * 128 + d4); }
    { const int rr = tid >> 5, d4 = (tid & 31) * 4;
      *(f32x4*)(As + rr * 132 + d4) = *(const f32x4*)(p.w_uq + (size_t)((r0 + rr) * 4 + h) * 192 + d4) * p.g_q[r0 + rr]; }
    __syncthreads();
    const int rr = tid & 15, ccg = tid >> 4;
    float acc[4] = {0.f, 0.f, 0.f, 0.f};
    for (int d4 = 0; d4 < 128; d4 += 4) { const f32x4 a = *(const f32x4*)(As + rr * 132 + d4);
#pragma unroll
        for (int i = 0; i < 4; ++i) { const f32x4 q = *(const f32x4*)(Bs + (ccg * 4 + i) * 132 + d4);
            acc[i] = fmaf(a[0], q[0], acc[i]); acc[i] = fmaf(a[1], q[1], acc[i]); acc[i] = fmaf(a[2], q[2], acc[i]); acc[i] = fmaf(a[3], q[3], acc[i]); } }
    bf16_t* wq = (bf16_t*)(p.ws + WS_WQ);
#pragma unroll
    for (int i = 0; i < 4; ++i) wq[(size_t)(h * 128 + ccg * 4 + i) * 256 + r0 + rr] = (bf16_t)(cvtpk(acc[i], 0.f) & 0xffffu);
    for (int e = tid; e < 1024; e += NTHREADS) { const int j = e & 63, r = r0 + (e >> 6);
        const float v = p.w_uq[(size_t)(r * 4 + h) * 192 + 128 + j] * p.g_q[r];
        wq[(size_t)(512 + h * 64 + j) * 256 + r] = (bf16_t)(cvtpk(v, 0.f) & 0xffffu); }
    __syncthreads();
}

DI void p0_transpose(const float* src, int ld_src, int n_valid, bf16_t* dst, int ld_dst, int kt, int nslab, int kind, float* lds) {
    const int tid = otid(), k0 = kt * 64, n0 = nslab * 256;
    float* tile = lds;
    f32x4 v[8];
#pragma unroll
    for (int i = 0; i < 8; ++i) { const int idx = tid + NTHREADS * i, kk = idx >> 6, nn4 = (idx & 63) * 4;
        v[i] = (f32x4){0.f, 0.f, 0.f, 0.f};
        if (n0 + nn4 < n_valid) v[i] = *(const f32x4*)(src + (size_t)(k0 + kk) * ld_src + n0 + nn4); }
#pragma unroll
    for (int i = 0; i < 8; ++i) { const int idx = tid + NTHREADS * i, kk = idx >> 6, nn4 = (idx & 63) * 4;
        tile[kk * 257 + nn4 + 0] = v[i][0]; tile[kk * 257 + nn4 + 1] = v[i][1]; tile[kk * 257 + nn4 + 2] = v[i][2]; tile[kk * 257 + nn4 + 3] = v[i][3]; }
    __syncthreads();
#pragma unroll
    for (int i = 0; i < 4; ++i) { const int c = tid + NTHREADS * i, nn = c >> 3, ks = (c & 7) * 8, n = n0 + nn;
        int drow = n;
        if (kind == 1) drow = (n >> 7) * 256 + (n & 127);
        else if (kind == 2) drow = (n >> 7) * 256 + 128 + (n & 127);
        u32x4 w;
        w.x = cvtpk(tile[(ks + 0) * 257 + nn], tile[(ks + 1) * 257 + nn]); w.y = cvtpk(tile[(ks + 2) * 257 + nn], tile[(ks + 3) * 257 + nn]);
        w.z = cvtpk(tile[(ks + 4) * 257 + nn], tile[(ks + 5) * 257 + nn]); w.w = cvtpk(tile[(ks + 6) * 257 + nn], tile[(ks + 7) * 257 + nn]);
        *(u32x4*)(dst + (size_t)drow * ld_dst + k0 + ks) = w; }
    __syncthreads();
}

DI void p0_prep(const Params& p, float* lds) {
    for (int it = blockIdx.x; it < N_ITEMS; it += gridDim.x) {
        int i = it;
        if (i < N_FMIX) { p0_fold_mix(p, i, lds); continue; } i -= N_FMIX;
        if (i < N_ADA) { p0_ada(p, i, lds); continue; } i -= N_ADA;
        if (i < N_FQ) { p0_fold_q(p, i, lds); continue; } i -= N_FQ;
        if (i < N_TR_IN) { p0_transpose(p.w_in, 960, 960, (bf16_t*)(p.ws + WS_WIN), 1024, i >> 2, i & 3, 0, lds); continue; } i -= N_TR_IN;
        if (i < N_TR_G) { p0_transpose(p.w_gate, DFF, DFF, (bf16_t*)(p.ws + WS_WGU), 1024, i / 11, i % 11, 1, lds); continue; } i -= N_TR_G;
        if (i < N_TR_U) { p0_transpose(p.w_up, DFF, DFF, (bf16_t*)(p.ws + WS_WGU), 1024, i / 11, i % 11, 2, lds); continue; } i -= N_TR_U;
        p0_transpose(p.w_down, DM, DM, (bf16_t*)(p.ws + WS_WDN), DFF, i >> 2, i & 3, 0, lds);
    }
}

DI void norm_mod_phase(const float* X, const float* g, const float* mod, int off_sh, int off_sc, bf16_t* H) {
    const int tid = otid(), lane = tid & 63, gw = blockIdx.x * 8 + (tid >> 6), nw = gridDim.x * 8;
    for (int base = gw * 16; base < M_TOK; base += nw * 16) {
        const int b = base >> 12;
        f32x4 gm[4], sh[4];
#pragma unroll
        for (int i = 0; i < 4; ++i) { const int col = i * 256 + lane * 4;
            gm[i] = *(const f32x4*)(g + col) * (*(const f32x4*)(mod + b * NMOD + off_sc + col) + 1.0f); sh[i] = *(const f32x4*)(mod + b * NMOD + off_sh + col); }
#pragma unroll 1
        for (int r0 = 0; r0 < 16; r0 += 4) {
            f32x4 v[4][4]; float ss[4];
#pragma unroll
            for (int rr = 0; rr < 4; ++rr)
#pragma unroll
                for (int i = 0; i < 4; ++i) v[rr][i] = *(const f32x4*)(X + (size_t)(base + r0 + rr) * DM + i * 256 + lane * 4);
#pragma unroll
            for (int rr = 0; rr < 4; ++rr) { float a = 0.f;
#pragma unroll
                for (int i = 0; i < 4; ++i) a += v[rr][i][0] * v[rr][i][0] + v[rr][i][1] * v[rr][i][1] + v[rr][i][2] * v[rr][i][2] + v[rr][i][3] * v[rr][i][3];
                ss[rr] = a; }
#pragma unroll
            for (int rr = 0; rr < 4; ++rr) ss[rr] = wave_sum(ss[rr]);
#pragma unroll
            for (int rr = 0; rr < 4; ++rr) { const float rstd = 1.0f / sqrtf(ss[rr] * (1.0f / DM) + EPS);
#pragma unroll
                for (int i = 0; i < 4; ++i) { const f32x4 y = v[rr][i] * rstd * gm[i] + sh[i];
                    u32x2 w; w.x = cvtpk(y[0], y[1]); w.y = cvtpk(y[2], y[3]);
                    *(u32x2*)(H + (size_t)(base + r0 + rr) * DM + i * 256 + lane * 4) = w; } }
        }
    }
}

DI void unpack8(const u32x4 q, float* f) {
    f[0] = __uint_as_float(q.x << 16); f[1] = __uint_as_float(q.x & 0xffff0000u); f[2] = __uint_as_float(q.y << 16); f[3] = __uint_as_float(q.y & 0xffff0000u);
    f[4] = __uint_as_float(q.z << 16); f[5] = __uint_as_float(q.z & 0xffff0000u); f[6] = __uint_as_float(q.w << 16); f[7] = __uint_as_float(q.w & 0xffff0000u);
}
DI void post_proj_phase(const Params& p) {
    const bf16_t* proj = (const bf16_t*)(p.ws + WS_PROJ);
    bf16_t* cq = (bf16_t*)(p.ws + WS_CQ); bf16_t* kb = (bf16_t*)(p.ws + WS_KB); bf16_t* amix = (bf16_t*)(p.ws + WS_AMIX);
    float* cosT = (float*)(p.ws + WS_COS); float* sinT = (float*)(p.ws + WS_SIN);
    const int tid = otid(), lane = tid & 63, gw = blockIdx.x * 8 + (tid >> 6), nw = gridDim.x * 8;
    const float freq = (float)exp2(-(double)(lane & 31) * (13.287712379549449 / 32.0));
    const float gkv0 = p.g_kv[lane * 2], gkv1 = p.g_kv[lane * 2 + 1];
    const int pc = lane * 8, w = 2 << (lane >> 4);
    for (int t0 = gw * 16; t0 < M_TOK; t0 += nw * 16) {
        const int s0 = t0 & (SEQ - 1);
        float sum[8];
#pragma unroll
        for (int e = 0; e < 8; ++e) sum[e] = 0.f;
#pragma unroll
        for (int i = 1; i < 16; ++i) {
            if (i < w && s0 - i >= 0) { float f[8]; unpack8(*(const u32x4*)(proj + (size_t)(t0 - i) * 1024 + 448 + pc), f);
#pragma unroll
                for (int e = 0; e < 8; ++e) sum[e] += f[e]; }
        }
#pragma unroll 2
        for (int k = 0; k < 16; ++k) {
            const int t = t0 + k, s = s0 + k;
            const bf16_t* row = proj + (size_t)t * 1024;
            const u32x2 wq = *(const u32x2*)(row + lane * 4);
            const unsigned wk = *(const unsigned*)(row + 256 + lane * 2);
            const u32x4 wu = *(const u32x4*)(row + 448 + pc);
            const bool drop = (s - w + 1 >= 0);
            u32x4 wd = (u32x4){0u, 0u, 0u, 0u};
            if (drop) wd = *(const u32x4*)(row - (size_t)(w - 1) * 1024 + 448 + pc);
            { const float a0 = __uint_as_float(wq.x << 16), a1 = __uint_as_float(wq.x & 0xffff0000u), a2 = __uint_as_float(wq.y << 16), a3 = __uint_as_float(wq.y & 0xffff0000u);
              const float ss = wave_sum(a0 * a0 + a1 * a1 + a2 * a2 + a3 * a3);
              const float rstd = 1.0f / sqrtf(ss * (1.0f / 256.0f) + EPS);
              u32x2 o; o.x = cvtpk(a0 * rstd, a1 * rstd); o.y = cvtpk(a2 * rstd, a3 * rstd);
              *(u32x2*)(cq + (size_t)t * 256 + lane * 4) = o; }
            { const float a0 = __uint_as_float(wk << 16), a1 = __uint_as_float(wk & 0xffff0000u);
              const float ss = wave_sum(a0 * a0 + a1 * a1);
              const float rstd = 1.0f / sqrtf(ss * (1.0f / 128.0f) + EPS);
              *(unsigned*)(kb + (size_t)t * 192 + lane * 2) = cvtpk(a0 * rstd * gkv0, a1 * rstd * gkv1); }
            if (lane < 32) {
                const float x1 = bf2f(row[384 + lane]), x2 = bf2f(row[384 + 32 + lane]);
                const float ang = (float)p.pos[t] * freq;
                float sn, cs; sincosf(ang, &sn, &cs);
                cosT[(size_t)t * 32 + lane] = cs; sinT[(size_t)t * 32 + lane] = sn;
                kb[(size_t)t * 192 + 128 + lane] = (bf16_t)(cvtpk(x1 * cs - x2 * sn, 0.f) & 0xffffu);
                kb[(size_t)t * 192 + 160 + lane] = (bf16_t)(cvtpk(x1 * sn + x2 * cs, 0.f) & 0xffffu);
            }
            { float f[8]; unpack8(wu, f);
#pragma unroll
              for (int e = 0; e < 8; ++e) sum[e] += f[e];
              const int cnt = (s + 1 < w) ? (s + 1) : w;
              const float inv = 1.0f / (float)cnt;
              u32x4 o;
              o.x = cvtpk(sum[0] * inv - f[0], sum[1] * inv - f[1]); o.y = cvtpk(sum[2] * inv - f[2], sum[3] * inv - f[3]);
              o.z = cvtpk(sum[4] * inv - f[4], sum[5] * inv - f[5]); o.w = cvtpk(sum[6] * inv - f[6], sum[7] * inv - f[7]);
              *(u32x4*)(amix + (size_t)t * 1024 + 512 + pc) = o;
              float d[8]; unpack8(wd, d);
#pragma unroll
              for (int e = 0; e < 8; ++e) sum[e] -= d[e]; }
        }
    }
}

namespace att {
constexpr float SCALE = 0.07216878364870322f;
constexpr float THR = 8.f;
constexpr int SHM_V = 64 * 128 * 2, SHM_K = 64 * 192 * 2;
constexpr int OFF_V = 0, OFF_K = 2 * SHM_V, OFF_WS = OFF_K + 2 * SHM_K, ATT_LDS = OFF_WS + 8 * 64 * 4;
#define KSWZ(row, colB) ((row) * 384 + ((colB) ^ (((row) & 7) << 4)))
#define SBAR() __builtin_amdgcn_sched_barrier(0)
DI int crow(int r, int hi) { return (r & 3) + 8 * (r >> 2) + 4 * hi; }

DI void partialSM(f32x16& p0, f32x16& p1, float& m_reg, float& mn, float& alpha) {
    constexpr float C = SCALE * 1.4426950408889634f;
    float pmax = p0[0];
#pragma unroll
    for (int r = 1; r < 16; ++r) pmax = fmaxf(pmax, p0[r]);
#pragma unroll
    for (int r = 0; r < 16; ++r) pmax = fmaxf(pmax, p1[r]);
    { auto rr = __builtin_amdgcn_permlane32_swap(__float_as_uint(pmax), __float_as_uint(pmax), false, false);
      pmax = fmaxf(__uint_as_float(rr[0]), __uint_as_float(rr[1])); }
    if (__builtin_expect(__all(pmax - m_reg <= THR / SCALE), 1)) { mn = m_reg; alpha = 1.f; }
    else { mn = fmaxf(m_reg, pmax); alpha = __builtin_amdgcn_exp2f((m_reg - mn) * C); m_reg = mn; }
    const float mnC = -mn * C;
#pragma unroll
    for (int r = 0; r < 16; ++r) p0[r] = fmaf(p0[r], C, mnC);
#pragma unroll
    for (int r = 0; r < 16; ++r) p1[r] = fmaf(p1[r], C, mnC);
#pragma unroll
    for (int r = 0; r < 16; ++r) p0[r] = __builtin_amdgcn_exp2f(p0[r]);
}
DI void finishSM(f32x16& p0, f32x16& p1, float alpha, float& l_reg, bf16x8& pa0, bf16x8& pa1, bf16x8& pa2, bf16x8& pa3) {
#pragma unroll
    for (int r = 0; r < 16; ++r) p1[r] = __builtin_amdgcn_exp2f(p1[r]);
    float ps = 0;
#pragma unroll
    for (int r = 0; r < 16; ++r) ps += p0[r];
#pragma unroll
    for (int r = 0; r < 16; ++r) ps += p1[r];
    { auto rr = __builtin_amdgcn_permlane32_swap(__float_as_uint(ps), __float_as_uint(ps), false, false);
      ps = __uint_as_float(rr[0]) + __uint_as_float(rr[1]); }
    l_reg = l_reg * alpha + ps;
#define PK4(P, BASE, OUT) do { unsigned a0 = cvtpk(P[BASE + 0], P[BASE + 1]), a1 = cvtpk(P[BASE + 2], P[BASE + 3]);   \
    unsigned b0 = cvtpk(P[BASE + 4], P[BASE + 5]), b1 = cvtpk(P[BASE + 6], P[BASE + 7]);                              \
    auto r0 = __builtin_amdgcn_permlane32_swap(a0, b0, false, false); auto r1 = __builtin_amdgcn_permlane32_swap(a1, b1, false, false); \
    u32x4 w = {r0[0], r1[0], r0[1], r1[1]}; OUT = __builtin_bit_cast(bf16x8, w); } while (0)
    PK4(p0, 0, pa0); PK4(p0, 8, pa1); PK4(p1, 0, pa2); PK4(p1, 8, pa3);
#undef PK4
}
DI void qkt(f32x16& p0, f32x16& p1, const char* Ks, const bf16x8* qr, int r32, int hi) {
#pragma unroll
    for (int r = 0; r < 16; ++r) { p0[r] = 0.f; p1[r] = 0.f; }
    const int sw = (r32 & 7) << 4, rb = r32 * 384;
    int o4[4];
#pragma unroll
    for (int q = 0; q < 4; ++q) o4[q] = rb + ((q * 32 + hi * 16) ^ sw);
#pragma unroll
    for (int d0 = 0; d0 < 12; ++d0) {
        const bf16x8 b0 = *reinterpret_cast<const bf16x8*>(Ks + o4[d0 & 3] + (d0 >> 2) * 128);
        const bf16x8 b1 = *reinterpret_cast<const bf16x8*>(Ks + o4[d0 & 3] + (d0 >> 2) * 128 + 32 * 384);
        p0 = __builtin_amdgcn_mfma_f32_32x32x16_bf16(b0, qr[d0], p0, 0, 0, 0);
        p1 = __builtin_amdgcn_mfma_f32_32x32x16_bf16(b1, qr[d0], p1, 0, 0, 0);
        if ((d0 & 3) == 3) SBAR(); }
}
DI int v_st(int k, int c) { const int kk = (k & ~0xC) | ((k & 4) << 1) | ((k & 8) >> 1); return ((kk >> 3) * 4 + (c >> 5)) * 512 + ((kk & 7) * 32 + (c & 31)) * 2; }
DI int v_rd_base(int lane) { return ((lane & 3) << 3) | (((lane >> 2) & 3) << 6) | (((lane >> 4) & 1) << 5) | (((lane >> 5) & 1) << 8); }
constexpr int v_rd_off(int d0, int ks, int half) { return d0 * 512 + ks * 4096 + half * 2048; }
template <int OFF> DI s16x4 tr_read(int vb) {
    s16x4 r; asm volatile("ds_read_b64_tr_b16 %0, %1 offset:%2" : "=&v"(r) : "v"(vb), "i"(OFF) : "memory"); return r;
}
template <int D0> DI void pv_one(f32x16& od, int vb, bf16x8 pa0, bf16x8 pa1, bf16x8 pa2, bf16x8 pa3) {
    const s16x4 l0 = tr_read<v_rd_off(D0, 0, 0)>(vb), h0 = tr_read<v_rd_off(D0, 0, 1)>(vb), l1 = tr_read<v_rd_off(D0, 1, 0)>(vb), h1 = tr_read<v_rd_off(D0, 1, 1)>(vb);
    const s16x4 l2 = tr_read<v_rd_off(D0, 2, 0)>(vb), h2 = tr_read<v_rd_off(D0, 2, 1)>(vb), l3 = tr_read<v_rd_off(D0, 3, 0)>(vb), h3 = tr_read<v_rd_off(D0, 3, 1)>(vb);
    asm volatile("s_waitcnt lgkmcnt(0)" ::: "memory"); SBAR();
#define PK(L, H) (bf16x8){L[0], L[1], L[2], L[3], H[0], H[1], H[2], H[3]}
    od = __builtin_amdgcn_mfma_f32_32x32x16_bf16(pa0, PK(l0, h0), od, 0, 0, 0);
    od = __builtin_amdgcn_mfma_f32_32x32x16_bf16(pa1, PK(l1, h1), od, 0, 0, 0);
    od = __builtin_amdgcn_mfma_f32_32x32x16_bf16(pa2, PK(l2, h2), od, 0, 0, 0);
    od = __builtin_amdgcn_mfma_f32_32x32x16_bf16(pa3, PK(l3, h3), od, 0, 0, 0);
#undef PK
}

DI void attn_unit(int b, int c, const bf16_t* __restrict__ qp, const bf16_t* __restrict__ Kb, const float* __restrict__ cosT, const float* __restrict__ sinT,
                  bf16_t* __restrict__ amix, char* lds) {
    int tid = threadIdx.x; asm volatile("" : "+v"(tid));
    const int wid = __builtin_amdgcn_readfirstlane(tid >> 6), lane = tid & 63, r32 = lane & 31, hi = lane >> 5, hq = wid >> 1;
    char* V_lds = lds + OFF_V; char* K_lds = lds + OFF_K;
    float* ws = (float*)(lds + OFF_WS) + wid * 64; float* li_l = ws; float* al_l = ws + 32;
    const int tok0 = b * SEQ + c * 64 + (wid & 1) * 32, tok = tok0 + r32;
    bf16x8 qr[12];
    const bf16_t* qrow = qp + (size_t)tok * 768;
#pragma unroll
    for (int d0 = 0; d0 < 8; ++d0) qr[d0] = *(const bf16x8*)(qrow + hq * 128 + d0 * 16 + hi * 8);
#pragma unroll
    for (int dd = 0; dd < 2; ++dd) {
        const int j0 = dd * 16 + hi * 8;
        const bf16x8 x1 = *(const bf16x8*)(qrow + 512 + hq * 64 + j0), x2 = *(const bf16x8*)(qrow + 512 + hq * 64 + 32 + j0);
        const f32x4 c0 = *(const f32x4*)(cosT + (size_t)tok * 32 + j0), c1 = *(const f32x4*)(cosT + (size_t)tok * 32 + j0 + 4);
        const f32x4 s0 = *(const f32x4*)(sinT + (size_t)tok * 32 + j0), s1 = *(const f32x4*)(sinT + (size_t)tok * 32 + j0 + 4);
        float o1[8], o2[8];
#pragma unroll
        for (int e = 0; e < 8; ++e) { const float a = bf2f((unsigned short)x1[e]), bb = bf2f((unsigned short)x2[e]);
            const float cs = e < 4 ? c0[e & 3] : c1[e & 3], sn = e < 4 ? s0[e & 3] : s1[e & 3];
            o1[e] = a * cs - bb * sn; o2[e] = a * sn + bb * cs; }
        u32x4 w1 = {cvtpk(o1[0], o1[1]), cvtpk(o1[2], o1[3]), cvtpk(o1[4], o1[5]), cvtpk(o1[6], o1[7])};
        u32x4 w2 = {cvtpk(o2[0], o2[1]), cvtpk(o2[2], o2[3]), cvtpk(o2[4], o2[5]), cvtpk(o2[6], o2[7])};
        qr[8 + dd] = __builtin_bit_cast(bf16x8, w1); qr[10 + dd] = __builtin_bit_cast(bf16x8, w2);
    }
    int kst[3], vst[3];
#pragma unroll
    for (int i = 0; i < 3; ++i) { const int id = tid + 512 * i, row = id / 24, ch = id - row * 24;
        kst[i] = KSWZ(row, ch * 16); vst[i] = ch < 16 ? v_st(row, ch * 8) : -1; }
    const char* Kg = (const char*)(Kb + (size_t)b * SEQ * 192);
    const int NT = c + 1;
    bf16x8 st[3];
#define SLOAD(j) do { _Pragma("unroll") for (int i_ = 0; i_ < 3; ++i_) st[i_] = *(const bf16x8*)(Kg + (size_t)(j) * SHM_K + (size_t)(tid + 512 * i_) * 16); } while (0)
#define SWRITE(bf) do { _Pragma("unroll") for (int i_ = 0; i_ < 3; ++i_) { *(bf16x8*)(K_lds + (bf) * SHM_K + kst[i_]) = st[i_]; \
        if (vst[i_] >= 0) *(bf16x8*)(V_lds + (bf) * SHM_V + vst[i_]) = st[i_]; } } while (0)
    float m_reg = -1e30f, l_reg = 0.f;
    f32x16 o[4];
#pragma unroll
    for (int d = 0; d < 4; ++d)
#pragma unroll
        for (int r = 0; r < 16; ++r) o[d][r] = 0.f;
    const int vb0 = (int)(uintptr_t)V_lds + v_rd_base(lane);
    SLOAD(0); SWRITE(0);
    if (NT > 1) SLOAD(1);
    for (int j = 0; j < NT; ++j) {
        __syncthreads();
        const int cur = j & 1;
        if (j + 1 < NT) { SWRITE(cur ^ 1); if (j + 2 < NT) SLOAD(j + 2); }
        f32x16 p0, p1; float mn, alpha; bf16x8 pa0, pa1, pa2, pa3;
        qkt(p0, p1, K_lds + cur * SHM_K, qr, r32, hi);
        partialSM(p0, p1, m_reg, mn, alpha);
        if (__any(alpha < 1.f)) {
            if (hi == 0) al_l[r32] = alpha;
            asm volatile("s_waitcnt lgkmcnt(0)" ::: "memory");
#pragma unroll
            for (int d = 0; d < 4; ++d)
#pragma unroll
                for (int r = 0; r < 16; ++r) o[d][r] *= al_l[crow(r, hi)];
        }
        finishSM(p0, p1, alpha, l_reg, pa0, pa1, pa2, pa3);
        const int vb = vb0 + cur * SHM_V;
        pv_one<0>(o[0], vb, pa0, pa1, pa2, pa3); pv_one<1>(o[1], vb, pa0, pa1, pa2, pa3); pv_one<2>(o[2], vb, pa0, pa1, pa2, pa3); pv_one<3>(o[3], vb, pa0, pa1, pa2, pa3);
    }
    if (hi == 0) li_l[r32] = l_reg;
    asm volatile("s_waitcnt lgkmcnt(0)" ::: "memory");
    int tid2 = threadIdx.x; asm volatile("" : "+v"(tid2));
    bf16_t* orow = amix + (size_t)(b * SEQ + c * 64 + ((tid2 >> 6) & 1) * 32) * 1024 + (tid2 >> 7) * 128 + (tid2 & 31);
#pragma unroll
    for (int r = 0; r < 16; ++r) { const int qq = crow(r, hi); const float rl = __builtin_amdgcn_rcpf(li_l[qq]);
#pragma unroll
        for (int d0 = 0; d0 < 4; ++d0) orow[(size_t)qq * 1024 + d0 * 32] = (bf16_t)(cvtpk(o[d0][r] * rl, 0.f) & 0xffffu); }
    __syncthreads();
#undef SLOAD
#undef SWRITE
}
DI void attn_phase(const Params& p, char* lds) {
    const bf16_t* qp = (const bf16_t*)(p.ws + WS_QP); const bf16_t* kb = (const bf16_t*)(p.ws + WS_KB);
    const float* cosT = (const float*)(p.ws + WS_COS); const float* sinT = (const float*)(p.ws + WS_SIN);
    bf16_t* amix = (bf16_t*)(p.ws + WS_AMIX);
    for (int u = blockIdx.x; u < 256; u += gridDim.x) {
        const int b = u & 7, cp = u >> 3;
#pragma unroll 1
        for (int half = 0; half < 2; ++half) attn_unit(b, half ? cp : 63 - cp, qp, kb, cosT, sinT, amix, lds);
    }
}
}

DI void final_norm_phase(float* X, const float* g) {
    const int tid = otid(), lane = tid & 63, gw = blockIdx.x * 8 + (tid >> 6), nw = gridDim.x * 8;
    f32x4 gg[4];
#pragma unroll
    for (int i = 0; i < 4; ++i) gg[i] = *(const f32x4*)(g + i * 256 + lane * 4);
    for (int base = gw * 16; base < M_TOK; base += nw * 16) {
#pragma unroll 1
        for (int r0 = 0; r0 < 16; r0 += 4) {
            f32x4 v[4][4]; float ss[4];
#pragma unroll
            for (int rr = 0; rr < 4; ++rr)
#pragma unroll
                for (int i = 0; i < 4; ++i) v[rr][i] = *(const f32x4*)(X + (size_t)(base + r0 + rr) * DM + i * 256 + lane * 4);
#pragma unroll
            for (int rr = 0; rr < 4; ++rr) { float a = 0.f;
#pragma unroll
                for (int i = 0; i < 4; ++i) a += v[rr][i][0] * v[rr][i][0] + v[rr][i][1] * v[rr][i][1] + v[rr][i][2] * v[rr][i][2] + v[rr][i][3] * v[rr][i][3];
                ss[rr] = a; }
#pragma unroll
            for (int rr = 0; rr < 4; ++rr) ss[rr] = wave_sum(ss[rr]);
#pragma unroll
            for (int rr = 0; rr < 4; ++rr) { const float rstd = 1.0f / sqrtf(ss[rr] * (1.0f / DM) + EPS);
#pragma unroll
                for (int i = 0; i < 4; ++i) *(f32x4*)(X + (size_t)(base + r0 + rr) * DM + i * 256 + lane * 4) = v[rr][i] * rstd * gg[i]; }
        }
    }
}

#define LAS __attribute__((address_space(3)))
#define XB_TMO      128
#define XB_XCNT(j)  (256  + 64 * (j))
#define XB_XSUB(j)  (1280 + 64 * (j))
#define XB_XGEN(j)  (2304 + 64 * (j))
#define XB_TOP      3328
#define XB_TOPGEN   3392
#define XCD_BAR_WORDS 3456
#define XB_SPIN_CAP (1u << 18)

__device__ __forceinline__ unsigned xb_ld(unsigned* p)              { return __hip_atomic_load(p, __ATOMIC_RELAXED, __HIP_MEMORY_SCOPE_AGENT); }
__device__ __forceinline__ unsigned xb_add(unsigned* p, unsigned v) { return __hip_atomic_fetch_add(p, v, __ATOMIC_RELAXED, __HIP_MEMORY_SCOPE_AGENT); }
__device__ __forceinline__ unsigned xb_xcc_id() { return (unsigned)__builtin_amdgcn_s_getreg((3 << 11) | 20) & 0xFu; }
#define XB_SPIN(cond, bar) do { unsigned _sp = 0; while (cond) { __builtin_amdgcn_s_sleep(1); \
    if ((++_sp & 255u) == 0u) { if (xb_ld(&(bar)[XB_TMO])) break; if (_sp > XB_SPIN_CAP) { atomicAdd(&(bar)[XB_TMO], 1u); break; } } } } while (0)

struct XcdBarrier {
    unsigned* bar; unsigned x;
    volatile LAS unsigned* st;
};

__device__ __forceinline__ XcdBarrier xcd_barrier_post(unsigned* bar, volatile LAS unsigned* st) {
    XcdBarrier b; b.bar = bar; b.x = xb_xcc_id(); b.st = st;
    if (threadIdx.x == 0) (void)xb_add(&bar[XB_XCNT(b.x)], 1u);
    return b;
}
__device__ __forceinline__ void xcd_barrier_complete(unsigned* bar, unsigned x, unsigned& nloc, unsigned& nx) {
    const unsigned G = gridDim.x * gridDim.y * gridDim.z;
    unsigned sum, cnt, mine, sp = 0u;
    for (;;) {
        sum = 0u; cnt = 0u; mine = 0u;
#pragma unroll
        for (unsigned j = 0; j < 16; ++j) { const unsigned c = xb_ld(&bar[XB_XCNT(j)]); sum += c; cnt += (c > 0u) ? 1u : 0u; mine = (j == x) ? c : mine; }
        if (sum == G) break;
        __builtin_amdgcn_s_sleep(1);
        if ((++sp & 255u) == 0u) { if (xb_ld(&bar[XB_TMO])) break; if (sp > XB_SPIN_CAP) { atomicAdd(&bar[XB_TMO], 1u); break; } }
    }
    nloc = mine > 0u ? mine : 1u; nx = cnt > 0u ? cnt : 1u;
}

__device__ __forceinline__ void xcd_barrier(const XcdBarrier& b) {
    asm volatile("s_waitcnt vmcnt(0)" ::: "memory");
    __syncthreads();
    if (threadIdx.x == 0) {
        unsigned* bar = b.bar;
        __builtin_amdgcn_s_waitcnt(0);
        unsigned nloc = b.st[0], nx = b.st[1];
        if (nloc == 0u) { xcd_barrier_complete(bar, b.x, nloc, nx); b.st[0] = nloc; b.st[1] = nx; }
        const unsigned old = xb_add(&bar[XB_XSUB(b.x)], 1u);
        const unsigned gen = old / nloc;
        if (old + 1u == (gen + 1u) * nloc) {
            __builtin_amdgcn_fence(__ATOMIC_RELEASE, "agent");
            asm volatile("s_waitcnt vmcnt(0)" ::: "memory");
            const unsigned og = xb_add(&bar[XB_TOP], 1u);
            const unsigned tg = og / nx;
            if (og + 1u == (tg + 1u) * nx) xb_add(&bar[XB_TOPGEN], 1u);
            else XB_SPIN(xb_ld(&bar[XB_TOPGEN]) == tg, bar);
            __builtin_amdgcn_fence(__ATOMIC_ACQUIRE, "agent");
            xb_add(&bar[XB_XGEN(b.x)], 1u);
            asm volatile("s_waitcnt vmcnt(0)" ::: "memory");
        } else {
            XB_SPIN(xb_ld(&bar[XB_XGEN(b.x)]) == gen, bar);
            __builtin_amdgcn_fence(__ATOMIC_ACQUIRE, "agent");
            asm volatile("s_waitcnt vmcnt(0)" ::: "memory");
        }
    }
    __syncthreads();
}
#ifndef PROBE_DUP
#define PROBE_DUP 0
#endif
__global__ void __launch_bounds__(NTHREADS, 2) mla_block_fwd(Params p) {
    extern __shared__ __attribute__((aligned(16))) unsigned char lds[];
    cg::grid_group grid = cg::this_grid();
    const int G = gridDim.x, bx = blockIdx.x;
    const float* mod = (const float*)(p.ws + WS_MOD);
    bf16_t* H = (bf16_t*)(p.ws + WS_H);
    PG8_LAS unsigned char* ring = (PG8_LAS unsigned char*)lds;
    volatile LAS unsigned* bst = (volatile LAS unsigned*)((LAS unsigned char*)lds + 131072 + 64);
    if (threadIdx.x == 0) { bst[0] = 0u; bst[1] = 0u; }
    __syncthreads();
    XcdBarrier xbar = xcd_barrier_post((unsigned*)(p.ws + WS_BAR), bst);
#define GSYNC() do { if (p.use_cg_sync) grid.sync(); else xcd_barrier(xbar); } while (0)

#define REP(k) for (int rep_ = 0; rep_ < 1 + ((PROBE_DUP >> (k)) & 1); ++rep_)
    if (PROBE_DUP & 512) { for (int q_ = 0; q_ < 10; ++q_) GSYNC(); }
    REP(0) { p0_prep(p, (float*)lds); GSYNC(); }
    REP(1) { norm_mod_phase(p.x, p.g_mix, mod, 0 * DM, 1 * DM, H); GSYNC(); }
    REP(2) { pg8::Gemm g{H, (const bf16_t*)(p.ws + WS_WIN), M_TOK, 1024, 1024}; pg8::StaticOrder S; S.init(M_TOK, 1024, G, bx);
      pg8::EpiStoreBf16 E{(bf16_t*)(p.ws + WS_PROJ), 1024};
      pg8::gemm_phase<pg8::EpiStoreBf16, pg8::StaticOrder, true, true>(ring, g, S, E); GSYNC(); }
    REP(3) { post_proj_phase(p); GSYNC(); }
    REP(4) { pg8::Gemm g{(const bf16_t*)(p.ws + WS_CQ), (const bf16_t*)(p.ws + WS_WQ), M_TOK, 768, 256}; pg8::StaticOrder S; S.init(M_TOK, 768, G, bx);
      pg8::EpiStoreBf16 E{(bf16_t*)(p.ws + WS_QP), 768};
      pg8::gemm_phase<pg8::EpiStoreBf16, pg8::StaticOrder, true, true>(ring, g, S, E); GSYNC(); }
    REP(5) { att::attn_phase(p, (char*)lds); GSYNC(); }
    REP(6) { pg8::Gemm g{(const bf16_t*)(p.ws + WS_AMIX), (const bf16_t*)(p.ws + WS_WMIX), M_TOK, 1024, 1024}; pg8::StaticOrder S; S.init(M_TOK, 1024, G, bx);
      pg8::EpiResid E{p.x, p.out, mod + 2 * DM};
      pg8::gemm_phase<pg8::EpiResid, pg8::StaticOrder, true, true>(ring, g, S, E); GSYNC(); }
    REP(7) { norm_mod_phase(p.out, p.g_ffn, mod, 3 * DM, 4 * DM, H); GSYNC(); }
    REP(8) { pg8::Gemm g{H, (const bf16_t*)(p.ws + WS_WGU), M_TOK, 2 * DFF, 1024}; pg8::StaticOrder S; S.init(M_TOK, 2 * DFF, G, bx);
      pg8::EpiSwiGLU E{(bf16_t*)(p.ws + WS_ACT), DFF};
      pg8::gemm_phase<pg8::EpiSwiGLU, pg8::StaticOrder, true, true>(ring, g, S, E); GSYNC(); }
    { pg8::Gemm g{(const bf16_t*)(p.ws + WS_ACT), (const bf16_t*)(p.ws + WS_WDN), M_TOK, 1024, DFF}; pg8::StaticOrder S; S.init(M_TOK, 1024, G, bx);
      pg8::EpiResid E{p.out, p.out, mod + 5 * DM};
      pg8::gemm_phase<pg8::EpiResid, pg8::StaticOrder, true, true>(ring, g, S, E); GSYNC(); }
    final_norm_phase(p.out, p.g_final);
}

extern "C" void kernel_launch(void* const* d_in, const int* in_sizes, int n_in, void* d_out, int out_size, void* d_ws, size_t ws_size, hipStream_t stream) {
    static int grid_blocks = 0;
    if (!grid_blocks) {
        if (n_in != 20 || out_size != M_TOK * DM || ws_size < WS_END) { fprintf(stderr, "kernel_launch: unexpected shapes n_in %d out %d ws %zu\n", n_in, out_size, ws_size); return; }
        if (hipFuncSetAttribute((const void*)mla_block_fwd, hipFuncAttributeMaxDynamicSharedMemorySize, LDS_BYTES) != hipSuccess) { fprintf(stderr, "kernel_launch: hipFuncSetAttribute failed\n"); return; }
        int dev = 0, cus = 0, per_cu = 0;
        hipGetDevice(&dev);
        hipDeviceGetAttribute(&cus, hipDeviceAttributeMultiprocessorCount, dev);
        if (hipOccupancyMaxActiveBlocksPerMultiprocessor(&per_cu, (const void*)mla_block_fwd, NTHREADS, LDS_BYTES) != hipSuccess || per_cu < 1) { fprintf(stderr, "kernel_launch: occupancy query failed\n"); return; }
        grid_blocks = cus * 1;
    }
    if (hipMemsetAsync((char*)d_ws + WS_BAR, 0, BAR_BYTES, stream) != hipSuccess) { fprintf(stderr, "kernel_launch: memset of the barrier words failed\n"); return; }
    Params p{};
    p.x = (const float*)d_in[0]; p.c = (const float*)d_in[1]; p.pos = (const int*)d_in[2]; p.w_ada = (const float*)d_in[3]; p.b_ada = (const float*)d_in[4];
    p.g_mix = (const float*)d_in[5]; p.w_in = (const float*)d_in[6]; p.g_q = (const float*)d_in[7]; p.g_kv = (const float*)d_in[8]; p.w_uq = (const float*)d_in[9];
    p.w_uk = (const float*)d_in[10]; p.w_uv = (const float*)d_in[11]; p.w_pool = (const float*)d_in[12]; p.pool_scale = (const float*)d_in[13]; p.w_o = (const float*)d_in[14];
    p.g_ffn = (const float*)d_in[15]; p.w_gate = (const float*)d_in[16]; p.w_up = (const float*)d_in[17]; p.w_down = (const float*)d_in[18]; p.g_final = (const float*)d_in[19];
    p.out = (float*)d_out; p.ws = (unsigned char*)d_ws;
    void* args[] = {&p};
    hipError_t e = hipLaunchCooperativeKernel((const void*)mla_block_fwd, dim3(grid_blocks), dim3(NTHREADS), args, LDS_BYTES, stream);
    if (e != hipSuccess) fprintf(stderr, "kernel_launch: cooperative launch failed: %s (grid %d)\n", hipGetErrorString(e), grid_blocks);
}
```
